# Optimizing an MI355X kernel written in HIP

```python
import jax, jax.numpy as jnp
from jax import lax
import numpy as np

D_MODEL = 2048
BATCH = 8
SEQ = 2048
DEPTH = 4
DEC_BATCH = 4
DEC_SEQ = 4096
PAST_LEN = 128

HEAD_DIM = 128
BLOCK = 128
WINDOW = 128
ATTN_WIDTH = D_MODEL * 3 // 4
N_HEADS = ATTN_WIDTH // HEAD_DIM
N_KV_HEADS = N_HEADS // 3
GROUP = N_HEADS // N_KV_HEADS
FOURIER_WIDTH = D_MODEL - ATTN_WIDTH
FOURIER_DIM = 128
N_FOURIER = FOURIER_WIDTH // FOURIER_DIM
CONV_WIDTH = D_MODEL // 2
CONV_K = 3
SG_WIDTH = D_MODEL - CONV_WIDTH
SG_DIM = 128
N_SG = SG_WIDTH // SG_DIM
CHUNK = 128
N_BUCKETS = 32
MAX_DISTANCE = 128
EPS = 1e-6
N_EVEN = (DEPTH + 1) // 2
N_ODD = DEPTH // 2
EVEN_SPLITS = [ATTN_WIDTH, N_KV_HEADS * HEAD_DIM, N_KV_HEADS * HEAD_DIM, FOURIER_WIDTH, ATTN_WIDTH, FOURIER_WIDTH]
ODD_SPLITS = [CONV_WIDTH, CONV_WIDTH, CONV_WIDTH, CONV_WIDTH, SG_WIDTH, SG_WIDTH, SG_WIDTH]
EVEN_IN = sum(EVEN_SPLITS)
ODD_IN = sum(ODD_SPLITS)

kernel_name = "hybrid_bidir_window_fnet_conv_gmlp"


def _rmsnorm(x, g):
    xf = x.astype(jnp.float32)
    r = lax.rsqrt(jnp.mean(xf * xf, axis=-1, keepdims=True) + EPS)
    return (xf * r).astype(x.dtype) * g


def _split(z, sizes):
    idx = [int(i) for i in np.cumsum(sizes)[:-1]]
    return jnp.split(z, idx, axis=-1)


def _t5_bucket(rel):
    nb = N_BUCKETS // 2
    ret = (rel > 0).astype(np.int32) * nb
    n = np.abs(rel)
    max_exact = nb // 2
    large = max_exact + (np.log(np.maximum(n, 1) / max_exact) / np.log(MAX_DISTANCE / max_exact)
                         * (nb - max_exact)).astype(np.int32)
    large = np.minimum(large, nb - 1)
    return (ret + np.where(n < max_exact, n, large)).astype(np.int32)


def _window_attention(q, k, v, rel_bias, sink):
    B, S = q.shape[0], q.shape[1]
    nb = S // BLOCK
    qb = q.reshape(B, nb, BLOCK, N_KV_HEADS, GROUP, HEAD_DIM)
    pad = ((0, 0), (BLOCK, BLOCK), (0, 0), (0, 0))

    def bands(t):
        tb = jnp.pad(t, pad).reshape(B, nb + 2, BLOCK, N_KV_HEADS, HEAD_DIM)
        return jnp.concatenate([tb[:, :-2], tb[:, 1:-1], tb[:, 2:]], axis=2)

    kb, vb = bands(k), bands(v)
    r = np.arange(BLOCK)[:, None]
    c = np.arange(3 * BLOCK)[None, :]
    rel = c - BLOCK - r
    pos_k = np.arange(nb)[:, None, None] * BLOCK + c[None] - BLOCK
    mask = jnp.asarray((np.abs(rel) <= WINDOW)[None] & (pos_k >= 0) & (pos_k < S))
    bias = jnp.take(rel_bias, jnp.asarray(_t5_bucket(rel)), axis=0)
    bias = jnp.transpose(bias, (2, 0, 1)).reshape(N_KV_HEADS, GROUP, BLOCK, 3 * BLOCK).astype(jnp.float32)

    s = jnp.einsum('bnqhgd,bnkhd->bnhgqk', qb, kb, preferred_element_type=jnp.float32) * (HEAD_DIM ** -0.5)
    s = jnp.where(mask[None, :, None, None], s + bias[None, None], -1e30)
    sink_l = sink.astype(jnp.float32).reshape(N_KV_HEADS, GROUP)[None, None, :, :, None, None]
    m = jnp.maximum(jnp.max(s, axis=-1, keepdims=True), sink_l)
    p = jnp.exp(s - m)
    denom = jnp.sum(p, axis=-1, keepdims=True) + jnp.exp(sink_l - m)
    o = jnp.einsum('bnhgqk,bnkhd->bnqhgd', (p / denom).astype(vb.dtype), vb)
    return o.reshape(B, S, N_HEADS * HEAD_DIM)


def _fourier(f, w_f, b_f):
    ff = jnp.fft.fft2(f.astype(jnp.float32), axes=(1, 3), norm='ortho').real.astype(f.dtype)
    return jnp.einsum('bsgc,gcd->bsgd', ff, w_f) + b_f


def _short_conv(h, w):
    hp = jnp.pad(h, ((0, 0), (1, 1), (0, 0)))
    return hp[:, :-2] * w[0] + hp[:, 1:-1] * w[1] + hp[:, 2:] * w[2]


def _spatial_gate(u, v, v_gain, w_s, b_s):
    B, S = u.shape[0], u.shape[1]
    nc = S // CHUNK
    vn = _rmsnorm(v.reshape(B, S, N_SG, SG_DIM), v_gain.reshape(N_SG, SG_DIM))
    vc = vn.reshape(B, nc, CHUNK, N_SG, SG_DIM)
    sv = jnp.einsum('gpq,bnqgc->bnpgc', w_s, vc) + jnp.transpose(b_s)[None, None, :, :, None]
    return u * sv.reshape(B, S, SG_WIDTH)


def _even_layer(x, g, w_in, w_out, q_gain, k_gain, sink, w_f, b_f, rel_bias):
    B, S = x.shape[0], x.shape[1]
    z = _rmsnorm(x, g) @ w_in
    q, k, v, f, ga, gf = _split(z, EVEN_SPLITS)
    q = _rmsnorm(q.reshape(B, S, N_HEADS, HEAD_DIM), q_gain)
    k = _rmsnorm(k.reshape(B, S, N_KV_HEADS, HEAD_DIM), k_gain)
    v = v.reshape(B, S, N_KV_HEADS, HEAD_DIM)
    a = _window_attention(q, k, v, rel_bias, sink) * jax.nn.silu(ga)
    fo = _fourier(f.reshape(B, S, N_FOURIER, FOURIER_DIM), w_f, b_f).reshape(B, S, FOURIER_WIDTH) * jax.nn.silu(gf)
    return x + jnp.concatenate([a, fo], axis=-1) @ w_out


def _odd_layer(x, g, w_in, conv_w, v_gain, w_s, b_s, w_out):
    z = _rmsnorm(x, g) @ w_in
    h, bg, cg, gc, u, v, gd = _split(z, ODD_SPLITS)
    co = (bg * _short_conv(cg * h, conv_w)) * jax.nn.silu(gc)
    so = _spatial_gate(u, v, v_gain, w_s, b_s) * jax.nn.silu(gd)
    return x + jnp.concatenate([co, so], axis=-1) @ w_out


def _trunk(x, norm_gain, rel_bias, w_in_e, w_out_e, q_gain, k_gain, sink, w_f, b_f,
           w_in_o, conv_w, v_gain, w_s, b_s, w_out_o):
    for l in range(DEPTH):
        i = l // 2
        if l % 2 == 0:
            x = _even_layer(x, norm_gain[l], w_in_e[i], w_out_e[i], q_gain[i], k_gain[i], sink[i],
                            w_f[i], b_f[i], rel_bias)
        else:
            x = _odd_layer(x, norm_gain[l], w_in_o[i], conv_w[i], v_gain[i], w_s[i], b_s[i], w_out_o[i])
    return x


def setup_inputs(seed: int = 0) -> dict:
    key = jax.random.key(seed)
    ks = jax.random.split(key, 20)
    nrm = lambda k, shape, s: jax.random.normal(k, shape, jnp.float32) * s
    return {
        "x_prompt": nrm(ks[0], (BATCH, SEQ, D_MODEL), 1.0),
        "x_sample": nrm(ks[1], (DEC_BATCH, DEC_SEQ, D_MODEL), 1.0),
        "norm_gain": 1.0 + nrm(ks[2], (DEPTH, D_MODEL), 0.02),
        "rel_bias": nrm(ks[3], (N_BUCKETS, N_HEADS), 0.1),
        "w_in_e": nrm(ks[4], (N_EVEN, D_MODEL, EVEN_IN), D_MODEL ** -0.5),
        "w_out_e": nrm(ks[5], (N_EVEN, ATTN_WIDTH + FOURIER_WIDTH, D_MODEL), (ATTN_WIDTH + FOURIER_WIDTH) ** -0.5),
        "q_gain": 1.0 + nrm(ks[6], (N_EVEN, HEAD_DIM), 0.02),
        "k_gain": 1.0 + nrm(ks[7], (N_EVEN, HEAD_DIM), 0.02),
        "sink": nrm(ks[8], (N_EVEN, N_HEADS), 0.1),
        "w_f": nrm(ks[9], (N_EVEN, N_FOURIER, FOURIER_DIM, FOURIER_DIM), FOURIER_DIM ** -0.5),
        "b_f": nrm(ks[10], (N_EVEN, N_FOURIER, FOURIER_DIM), 0.02),
        "w_in_o": nrm(ks[11], (N_ODD, D_MODEL, ODD_IN), D_MODEL ** -0.5),
        "conv_w": nrm(ks[12], (N_ODD, CONV_K, CONV_WIDTH), CONV_K ** -0.5),
        "v_gain": 1.0 + nrm(ks[13], (N_ODD, SG_WIDTH), 0.02),
        "w_s": nrm(ks[14], (N_ODD, N_SG, CHUNK, CHUNK), CHUNK ** -0.5),
        "b_s": nrm(ks[15], (N_ODD, N_SG, CHUNK), 0.02),
        "w_out_o": nrm(ks[16], (N_ODD, CONV_WIDTH + SG_WIDTH, D_MODEL), (CONV_WIDTH + SG_WIDTH) ** -0.5),
    }


def reference(x_prompt, x_sample, norm_gain, rel_bias, w_in_e, w_out_e, q_gain, k_gain, sink, w_f, b_f,
              w_in_o, conv_w, v_gain, w_s, b_s, w_out_o):
    y_prompt = _trunk(x_prompt, norm_gain, rel_bias, w_in_e, w_out_e, q_gain, k_gain, sink, w_f, b_f,
                      w_in_o, conv_w, v_gain, w_s, b_s, w_out_o)
    y_sample = _trunk(x_sample, norm_gain, rel_bias, w_in_e, w_out_e, q_gain, k_gain, sink, w_f, b_f,
                      w_in_o, conv_w, v_gain, w_s, b_s, w_out_o)
    return (y_prompt, y_sample)
```

```cpp
#include <hip/hip_runtime.h>
#include <hip/hip_cooperative_groups.h>
#include <cstdio>
#include <cstdint>
namespace cg = cooperative_groups;

#define LAS __attribute__((address_space(3)))
typedef unsigned short bf16_t;
typedef short bf16x8 __attribute__((ext_vector_type(8)));
typedef float f32x4 __attribute__((ext_vector_type(4)));
typedef unsigned u32x4 __attribute__((ext_vector_type(4)));
typedef unsigned u32x2 __attribute__((ext_vector_type(2)));

constexpr int T = 32768, TP = 16384, D = 2048;
constexpr float EPS = 1e-6f;
constexpr float LOG2E = 1.4426950408889634f;
constexpr size_t MiB = 1048576;
constexpr size_t OFF_BIAS = 0;
constexpr size_t OFF_W2   = 0x10000;
constexpr size_t OFF_WSB  = 0x90000;
constexpr size_t OFF_BAR  = 0x180000;
constexpr size_t OFF_RSS  = 2 * MiB;
constexpr size_t OFF_VSS  = 6 * MiB;
constexpr size_t OFF_WIN  = 10 * MiB;
constexpr size_t OFF_WOUT = 38 * MiB;
constexpr size_t OFF_XB   = 46 * MiB;
constexpr size_t DO_PQ = 0, DO_TRIG = 64 * MiB, DO_FE = 96 * MiB, DO_FO = 112 * MiB;
constexpr size_t TRIG_HALF = (size_t)2048 * 4096 * 2;
constexpr size_t OFF_Z    = 174 * MiB;
constexpr size_t OFF_Z0   = OFF_Z;
constexpr size_t OFF_ZK   = OFF_Z + 128 * MiB;
constexpr size_t OFF_ZVT  = OFF_Z + 160 * MiB;
constexpr size_t OFF_ZGA  = OFF_Z + 192 * MiB;
constexpr size_t OFF_ZFT  = OFF_Z + 288 * MiB;
constexpr size_t OFF_ZM   = OFF_Z + 128 * MiB;
constexpr size_t OFF_ZVT2 = OFF_Z + 192 * MiB;
constexpr size_t WS_NEED  = OFF_Z + 320 * MiB;

constexpr int LDS_BYTES = 163840;
constexpr int XLDS_OFF = 131072;

struct Params {
    const float *x_prompt, *x_sample, *norm_gain, *rel_bias, *w_in_e, *w_out_e, *q_gain, *k_gain, *sink, *w_f, *b_f, *w_in_o, *conv_w, *v_gain, *w_s, *b_s, *w_out_o;
    float* out; unsigned char* ws;
};

__device__ __forceinline__ unsigned cvt_pk_bf16(float lo, float hi) { unsigned r; asm("v_cvt_pk_bf16_f32 %0, %1, %2" : "=v"(r) : "v"(lo), "v"(hi)); return r; }
__device__ __forceinline__ float bf_lo(unsigned u) { return __builtin_bit_cast(float, u << 16); }
__device__ __forceinline__ float bf_hi(unsigned u) { return __builtin_bit_cast(float, u & 0xffff0000u); }
__device__ __forceinline__ float silu_f(float x) { return x * __builtin_amdgcn_rcpf(1.f + __builtin_amdgcn_exp2f(-LOG2E * x)); }
__device__ __forceinline__ float wave_sum(float v) {
#pragma unroll
    for (int o = 1; o < 64; o <<= 1) v += __shfl_xor(v, o);
    return v;
}
#define LDS_WAIT() asm volatile("s_waitcnt lgkmcnt(0)" ::: "memory")

namespace pg8 {
constexpr int BM = 256, BK = 64, HALF = 128, HTB = HALF * BK * 2, NXCD = 8, WGM = 8;
__device__ __forceinline__ int lds_byte(int r, int c) { const int st = (r >> 4) * 2 + (c >> 5), rr = r & 15, cc = c & 31, ob = rr * 64 + cc * 2; return st * 1024 + (ob ^ (((ob >> 9) & 1) << 5)); }
__device__ __forceinline__ void stage_rc(int b, int& R, int& C) { const int st = b / 1024, sb = b % 1024, swz = sb ^ (((sb >> 9) & 1) << 5); R = (st >> 1) * 16 + swz / 64; C = (st & 1) * 32 + (swz % 64) / 2; }
__device__ __forceinline__ int perm32(int rho) { const int n = rho >> 4, i = rho & 15; return 8 * (i >> 2) + 4 * n + (i & 3); }

struct Unit { int pm, pn, aux; };

struct GemmSched {
    int nM, nN, nwg, G, c; const char* A; const char* B; size_t tA, tB;
    __device__ void init(int M, int N, int G_, int c_, const void* A_, size_t lda, const void* B_, size_t ldb) { nM = M / BM; nN = N / BM; nwg = nM * nN; G = G_; c = c_; A = (const char*)A_; B = (const char*)B_; tA = 256 * lda * 2; tB = 256 * ldb * 2; }
    __device__ bool next(int i, Unit& u) const {
        const long L = (long)i * G + c; if (L >= nwg) return false;
        int wgid = (int)L; { const int q = nwg / NXCD, r = nwg % NXCD, xcd = wgid % NXCD, off = wgid / NXCD; wgid = (xcd < r ? xcd * (q + 1) : r * (q + 1) + (xcd - r) * q) + off; }
        const int nig = WGM * nN, gid = wgid / nig, fm = gid * WGM, gsz = (nM - fm) < WGM ? (nM - fm) : WGM;
        u.pm = fm + ((wgid % nig) % gsz); u.pn = (wgid % nig) / gsz; u.aux = 0; return true;
    }
    __device__ const char* aptr(const Unit& u) const { return A + (size_t)u.pm * tA; }
    __device__ const char* bptr(const Unit& u) const { return B + (size_t)u.pn * tB; }
};

struct DftSched {
    int G, c; bool lng; const char* trig; const char* fe; const char* fo;
    __device__ bool next(int i, Unit& u) const {
        const long L = (long)i * G + (lng ? c : (G - 1 - c)); if (L >= 128) return false;
        const int l = (int)L;
        if (lng) { u.aux = l >> 5; u.pm = (l & 31) >> 1; u.pn = l & 1; } else { u.aux = l >> 4; u.pm = (l & 15) >> 1; u.pn = l & 1; }
        return true;
    }
    __device__ const char* aptr(const Unit& u) const {
        if (lng) { const int cs = u.pm >= 8, k0 = (u.pm - 8 * cs) * 256; return trig + (size_t)cs * TRIG_HALF + (size_t)k0 * 4096 * 2; }
        const int cs = u.pm >= 4, k0 = (u.pm - 4 * cs) * 256; return trig + (size_t)cs * TRIG_HALF + (size_t)(2 * k0) * 4096 * 2;
    }
    __device__ const char* bptr(const Unit& u) const {
        const int cs = lng ? (u.pm >= 8) : (u.pm >= 4);
        const size_t tok = lng ? (size_t)TP + (size_t)u.aux * 4096 : (size_t)u.aux * 2048;
        return (cs ? fo : fe) + ((size_t)u.pn * 256 * (T / 2) + tok / 2) * 2;
    }
};

template <class Epi, class Sched>
__device__ __forceinline__ void gemm_phase(LAS unsigned char* lds, const int K, const int lda, const int ldb, const Sched& S, const Epi& E) {
    int tid = threadIdx.x; asm volatile("" : "+v"(tid));
    const int wid = __builtin_amdgcn_readfirstlane(tid >> 6), lane = tid & 63, wr = wid >> 2, wc = wid & 3, fr = lane & 15, fq = lane >> 4;
    const int nt = K / BK;
    unsigned voffA[2], voffB[2];
#pragma unroll
    for (int i = 0; i < 2; ++i) { int R, C; stage_rc(tid * 16 + i * 8192, R, C); const int Rb = (R & ~31) + perm32(R & 31);
        voffA[i] = (unsigned)(R * lda + C) * 2u; voffB[i] = (unsigned)(Rb * ldb + C) * 2u; }
    const size_t kstep = (size_t)(BK * 2);
    const size_t hA = (size_t)HALF * lda * 2, hB = (size_t)HALF * ldb * 2;
    const unsigned ldsw = (unsigned)wid * 1024u;
    const int aoff = lds_byte(wr * 64 + fr, fq * 8), boff = lds_byte(wc * 32 + fr, fq * 8);
#define PG8_SA(b, h) (((b) * 2 + (h)) * HTB)
#define PG8_SB(b, h) ((4 + (b) * 2 + (h)) * HTB)
#define PG8_STAGE(bufoff, gbase, voff) do { _Pragma("unroll") for (int _i = 0; _i < 2; ++_i) \
        __builtin_amdgcn_global_load_lds((const unsigned*)((const char*)(gbase) + (voff)[_i]), (LAS unsigned*)(lds + (bufoff) + ldsw + _i * 8192), 16, 0, 0); } while (0)
#define PG8_LDA(dst, b, h) do { _Pragma("unroll") for (int m = 0; m < 4; ++m) _Pragma("unroll") for (int k = 0; k < 2; ++k) dst[m][k] = *(const LAS bf16x8*)(lds + PG8_SA(b, h) + aoff + m * 2048 + k * 1024); } while (0)
#define PG8_LDB(dst, b, h) do { _Pragma("unroll") for (int n = 0; n < 2; ++n) _Pragma("unroll") for (int k = 0; k < 2; ++k) dst[n][k] = *(const LAS bf16x8*)(lds + PG8_SB(b, h) + boff + n * 2048 + k * 1024); } while (0)
#define PG8_MMA(ai, bj, At, Bt) do { __builtin_amdgcn_s_setprio(1); _Pragma("unroll") for (int m = 0; m < 4; ++m) _Pragma("unroll") for (int n = 0; n < 2; ++n) _Pragma("unroll") for (int k = 0; k < 2; ++k) \
        acc[ai][bj][m][n] = __builtin_amdgcn_mfma_f32_16x16x32_bf16(Bt[n][k], At[m][k], acc[ai][bj][m][n], 0, 0, 0); __builtin_amdgcn_s_setprio(0); } while (0)
#define PG8_WAIT_V(n) asm volatile("s_waitcnt vmcnt(" #n ")" ::: "memory")
#define PG8_WAIT_L(n) asm volatile("s_waitcnt lgkmcnt(" #n ")" ::: "memory")
#define PG8_BAR __builtin_amdgcn_s_barrier()
#define PG8_SCHED __builtin_amdgcn_sched_barrier(0)
    Unit cur, nxt; int ui = 0;
    if (!S.next(0, cur)) return;
    f32x4 acc[2][2][4][2];
#pragma unroll
    for (int a = 0; a < 2; ++a)
#pragma unroll
        for (int b = 0; b < 2; ++b)
#pragma unroll
            for (int m = 0; m < 4; ++m)
#pragma unroll
                for (int n = 0; n < 2; ++n) acc[a][b][m][n] = (f32x4){0.f, 0.f, 0.f, 0.f};
    bf16x8 At[4][2], B0[2][2], B1[2][2];
    const char* cA = S.aptr(cur); const char* cB = S.bptr(cur);
    PG8_STAGE(PG8_SB(0, 0), cB, voffB); PG8_STAGE(PG8_SB(0, 1), cB + hB, voffB); PG8_STAGE(PG8_SA(0, 0), cA, voffA); PG8_STAGE(PG8_SA(0, 1), cA + hA, voffA);
    if (wr == 1) PG8_BAR;
    PG8_WAIT_V(2); PG8_BAR;
    PG8_STAGE(PG8_SB(1, 0), cB + kstep, voffB); PG8_STAGE(PG8_SA(1, 0), cA + kstep, voffA); PG8_STAGE(PG8_SB(1, 1), cB + hB + kstep, voffB);
    PG8_WAIT_V(6); PG8_BAR;
    for (;;) {
        const bool has_next = S.next(ui + 1, nxt);
        const char* nA = has_next ? S.aptr(nxt) : cA; const char* nB = has_next ? S.bptr(nxt) : cB;
        for (int t = 0; t < nt; t += 2) {
            const bool last = (t == nt - 2);
            const char* a1 = cA + (size_t)(t + 1) * kstep;
            const char* a2 = last ? nA : cA + (size_t)(t + 2) * kstep; const char* b2 = last ? nB : cB + (size_t)(t + 2) * kstep;
            const char* a3 = a2 + kstep; const char* b3 = b2 + kstep;
            PG8_LDB(B0, 0, 0); PG8_LDB(B1, 0, 1); PG8_SCHED; PG8_LDA(At, 0, 0); PG8_STAGE(PG8_SA(1, 1), a1 + hA, voffA);
            PG8_WAIT_V(8); PG8_WAIT_L(0); PG8_BAR; PG8_MMA(0, 0, At, B0); PG8_MMA(0, 1, At, B1); PG8_BAR; PG8_SCHED;
            PG8_LDA(At, 0, 1); PG8_STAGE(PG8_SB(0, 0), b2, voffB); PG8_STAGE(PG8_SB(0, 1), b2 + hB, voffB); PG8_STAGE(PG8_SA(0, 0), a2, voffA);
            PG8_WAIT_V(8); PG8_WAIT_L(0); PG8_BAR; PG8_MMA(1, 0, At, B0); PG8_MMA(1, 1, At, B1); PG8_BAR; PG8_SCHED;
            PG8_LDB(B0, 1, 0); PG8_LDB(B1, 1, 1); PG8_SCHED; PG8_LDA(At, 1, 0); PG8_STAGE(PG8_SA(0, 1), a2 + hA, voffA);
            PG8_WAIT_V(8); PG8_WAIT_L(0); PG8_BAR; PG8_MMA(0, 0, At, B0); PG8_MMA(0, 1, At, B1); PG8_BAR; PG8_SCHED;
            PG8_LDA(At, 1, 1); PG8_STAGE(PG8_SB(1, 0), b3, voffB); PG8_STAGE(PG8_SB(1, 1), b3 + hB, voffB); PG8_STAGE(PG8_SA(1, 0), a3, voffA);
            PG8_WAIT_V(8); PG8_WAIT_L(0); PG8_BAR; PG8_MMA(1, 0, At, B0); PG8_MMA(1, 1, At, B1); PG8_BAR; PG8_SCHED;
        }
        if (wr == 0) PG8_BAR;
        E(acc, cur, wr, wc, fr, fq, lds + XLDS_OFF, wid, lane);
        if (!has_next) break;
#pragma unroll
        for (int a = 0; a < 2; ++a)
#pragma unroll
            for (int b = 0; b < 2; ++b)
#pragma unroll
                for (int m = 0; m < 4; ++m)
#pragma unroll
                    for (int n = 0; n < 2; ++n) acc[a][b][m][n] = (f32x4){0.f, 0.f, 0.f, 0.f};
        cur = nxt; cA = nA; cB = nB; ++ui;
        if (wr == 1) PG8_BAR;
    }
    PG8_WAIT_V(0);
    PG8_BAR;
#undef PG8_SA
#undef PG8_SB
#undef PG8_STAGE
#undef PG8_LDA
#undef PG8_LDB
#undef PG8_MMA
#undef PG8_WAIT_V
#undef PG8_WAIT_L
#undef PG8_BAR
#undef PG8_SCHED
}
}
using pg8::Unit;

__device__ __forceinline__ void tstore_sub(const f32x4 (&v)[4][2], bf16_t* dst  , LAS unsigned char* x, int fr, int fq, int lane) {
#pragma unroll
    for (int m = 0; m < 4; ++m)
#pragma unroll
        for (int n = 0; n < 2; ++n)
#pragma unroll
            for (int j = 0; j < 4; ++j) {
                const int ch = 8 * fq + 4 * n + j, tok = 16 * m + fr;
                const unsigned b = cvt_pk_bf16(v[m][n][j], 0.f);
                *(LAS unsigned short*)(x + ch * 128 + ((((tok >> 3) ^ fq) << 4) | ((tok & 7) << 1))) = (unsigned short)b;
            }
    LDS_WAIT();
#pragma unroll
    for (int i = 0; i < 4; ++i) {
        const int q = lane + 64 * i, ch = q >> 3, tc = q & 7;
        const u32x4 o = *(const LAS u32x4*)(x + ch * 128 + ((tc ^ ((ch >> 3) & 3)) << 4));
        *(u32x4*)(dst + (size_t)ch * T + tc * 8) = o;
    }
    LDS_WAIT();
}

template <bool ODD> struct EpiIn {
    const float* rss; unsigned char* ws;
    __device__ __forceinline__ void operator()(const f32x4 (&acc)[2][2][4][2], const Unit& u, int wr, int wc, int fr, int fq, LAS unsigned char* xs, int wid, int lane) const {
        LAS unsigned char* x = xs + wid * 4096;
        const int row0 = u.pm * 256 + wr * 64;
        float rs[2][4];
#pragma unroll
        for (int ai = 0; ai < 2; ++ai) {
            const f32x4* pp = (const f32x4*)(rss + (size_t)(row0 + ai * 128 + lane) * 8);
            const f32x4 v0 = pp[0], v1 = pp[1];
            const float s = ((v0[0] + v0[1]) + (v0[2] + v0[3])) + ((v1[0] + v1[1]) + (v1[2] + v1[3]));
            const float r = rsqrtf(s * (1.f / D) + EPS);
#pragma unroll
            for (int m = 0; m < 4; ++m) rs[ai][m] = __shfl(r, 16 * m + fr);
        }
        const int pn = u.pn;
        int mode; bf16_t* base; int ldc;
        if (!ODD) {
            if (pn < 8) { mode = 0; base = (bf16_t*)(ws + OFF_Z0) + 256 * pn; ldc = 2048; }
            else if (pn < 10) { mode = 0; base = (bf16_t*)(ws + OFF_ZK) + 256 * (pn - 8); ldc = 512; }
            else if (pn < 16) { mode = 0; base = (bf16_t*)(ws + OFF_ZGA) + 256 * (pn - 10); ldc = 1536; }
            else if (pn < 18) { mode = 3; base = (bf16_t*)(ws + OFF_ZVT) + (size_t)256 * (pn - 16) * T; ldc = 0; }
            else { mode = 3; base = (bf16_t*)(ws + OFF_ZFT) + (size_t)256 * (pn - 18) * T; ldc = 0; }
        } else {
            if (pn < 8) { mode = 1; base = (bf16_t*)(ws + OFF_ZM) + 128 * pn; ldc = 1024; }
            else if (pn < 24) { mode = 2; base = (bf16_t*)(ws + OFF_Z0) + 128 * (pn - 8); ldc = 2048; }
            else { mode = 3; base = (bf16_t*)(ws + OFF_ZVT2) + (size_t)256 * (pn - 24) * T; ldc = 0; }
        }
        if (mode == 0) {
#pragma unroll
            for (int ai = 0; ai < 2; ++ai)
#pragma unroll
                for (int m = 0; m < 4; ++m) {
                    const float r = rs[ai][m];
                    bf16_t* rowp = base + (size_t)(row0 + ai * 128 + m * 16 + fr) * ldc + wc * 32 + 8 * fq;
#pragma unroll
                    for (int bj = 0; bj < 2; ++bj) { const f32x4 v0 = acc[ai][bj][m][0] * r, v1 = acc[ai][bj][m][1] * r;
                        u32x4 w; w.x = cvt_pk_bf16(v0[0], v0[1]); w.y = cvt_pk_bf16(v0[2], v0[3]); w.z = cvt_pk_bf16(v1[0], v1[1]); w.w = cvt_pk_bf16(v1[2], v1[3]);
                        *(u32x4*)(rowp + bj * 128) = w; }
                    __builtin_amdgcn_sched_barrier(0);
                }
        } else if (mode == 1 || mode == 2) {
#pragma unroll
            for (int ai = 0; ai < 2; ++ai)
#pragma unroll
                for (int m = 0; m < 4; ++m) {
                    const float r = rs[ai][m];
                    bf16_t* rowp = base + (size_t)(row0 + ai * 128 + m * 16 + fr) * ldc + wc * 32 + 8 * fq;
                    float o[8];
#pragma unroll
                    for (int n = 0; n < 2; ++n)
#pragma unroll
                        for (int j = 0; j < 4; ++j) { const float a = acc[ai][0][m][n][j] * r, b = acc[ai][1][m][n][j] * r; o[4 * n + j] = (mode == 1) ? a * b : a * silu_f(b); }
                    u32x4 w; w.x = cvt_pk_bf16(o[0], o[1]); w.y = cvt_pk_bf16(o[2], o[3]); w.z = cvt_pk_bf16(o[4], o[5]); w.w = cvt_pk_bf16(o[6], o[7]);
                    *(u32x4*)rowp = w;
                    __builtin_amdgcn_sched_barrier(0);
                }
        } else {
#pragma unroll
            for (int ai = 0; ai < 2; ++ai)
#pragma unroll
                for (int bj = 0; bj < 2; ++bj) {
                    f32x4 v[4][2];
#pragma unroll
                    for (int m = 0; m < 4; ++m) { v[m][0] = acc[ai][bj][m][0] * rs[ai][m]; v[m][1] = acc[ai][bj][m][1] * rs[ai][m]; }
                    if (ODD) {
                        float* vss = (float*)(ws + OFF_VSS);
#pragma unroll
                        for (int m = 0; m < 4; ++m) {
                            float s = 0.f;
#pragma unroll
                            for (int n = 0; n < 2; ++n) s += (v[m][n][0] * v[m][n][0] + v[m][n][1] * v[m][n][1]) + (v[m][n][2] * v[m][n][2] + v[m][n][3] * v[m][n][3]);
                            s += __shfl_xor(s, 16); s += __shfl_xor(s, 32);
                            if (fq == 0) vss[(size_t)(row0 + ai * 128 + m * 16 + fr) * 32 + (2 * (pn - 24) + bj) * 4 + wc] = s;
                        }
                    }
                    tstore_sub(v, base + (size_t)(bj * 128 + wc * 32) * T + row0 + ai * 128, x, fr, fq, lane);
                }
        }
    }
};

template <bool SRCF32, bool LAST> struct EpiOut {
    const float* xo_p; const float* xo_s;
    float* out; bf16_t* xb; float* rss;
    __device__ __forceinline__ void operator()(const f32x4 (&acc)[2][2][4][2], const Unit& u, int wr, int wc, int fr, int fq, LAS unsigned char* xs, int wid, int lane) const {
        const int row0 = u.pm * 256 + wr * 64, col0 = u.pn * 256 + wc * 32 + 8 * fq;
        const float* xo = (row0 < TP) ? xo_p : xo_s - (size_t)TP * D;
        LAS float* P = (LAS float*)xs;
        u32x4 raw[2][4][2];
        if (!SRCF32) {
#pragma unroll
            for (int ai = 0; ai < 2; ++ai)
#pragma unroll
                for (int m = 0; m < 4; ++m)
#pragma unroll
                    for (int bj = 0; bj < 2; ++bj) raw[ai][m][bj] = *(const u32x4*)(xb + (size_t)(row0 + ai * 128 + m * 16 + fr) * D + col0 + bj * 128);
        }
#pragma unroll
        for (int ai = 0; ai < 2; ++ai) {
            f32x4 xf[4][2][2];
            if (SRCF32) {
#pragma unroll
                for (int m = 0; m < 4; ++m)
#pragma unroll
                    for (int bj = 0; bj < 2; ++bj) { const size_t o = (size_t)(row0 + ai * 128 + m * 16 + fr) * D + col0 + bj * 128; xf[m][bj][0] = *(const f32x4*)(xo + o); xf[m][bj][1] = *(const f32x4*)(xo + o + 4); }
            }
#pragma unroll
            for (int m = 0; m < 4; ++m) {
                const size_t row = (size_t)(row0 + ai * 128 + m * 16 + fr);
                float ss = 0.f;
#pragma unroll
                for (int bj = 0; bj < 2; ++bj) {
                    const size_t o = row * D + col0 + bj * 128;
                    f32x4 x0, x1;
                    if (SRCF32) { x0 = xf[m][bj][0]; x1 = xf[m][bj][1]; }
                    else { const u32x4 r = raw[ai][m][bj]; x0 = (f32x4){bf_lo(r.x), bf_hi(r.x), bf_lo(r.y), bf_hi(r.y)}; x1 = (f32x4){bf_lo(r.z), bf_hi(r.z), bf_lo(r.w), bf_hi(r.w)}; }
                    const f32x4 v0 = x0 + acc[ai][bj][m][0], v1 = x1 + acc[ai][bj][m][1];
                    if (LAST) { *(f32x4*)(out + o) = v0; *(f32x4*)(out + o + 4) = v1; }
                    else {
                        ss += (v0[0] * v0[0] + v0[1] * v0[1]) + (v0[2] * v0[2] + v0[3] * v0[3]) + (v1[0] * v1[0] + v1[1] * v1[1]) + (v1[2] * v1[2] + v1[3] * v1[3]);
                        u32x4 w; w.x = cvt_pk_bf16(v0[0], v0[1]); w.y = cvt_pk_bf16(v0[2], v0[3]); w.z = cvt_pk_bf16(v1[0], v1[1]); w.w = cvt_pk_bf16(v1[2], v1[3]); *(u32x4*)(xb + o) = w;
                    }
                }
                if (!LAST) { ss += __shfl_xor(ss, 16); ss += __shfl_xor(ss, 32);
                    if (fq == 0) P[(ai * 128 + wr * 64 + m * 16 + fr) * 4 + wc] = ss; }
            }
            if (SRCF32) __builtin_amdgcn_sched_barrier(0);
        }
        if (!LAST) {
            LDS_WAIT();
            __builtin_amdgcn_s_barrier();
            const int tid = wid * 64 + lane;
            if (tid < 256) { const f32x4 v = *(const LAS f32x4*)(P + tid * 4); rss[(size_t)(u.pm * 256 + tid) * 8 + u.pn] = (v[0] + v[1]) + (v[2] + v[3]); }
            LDS_WAIT();
        }
    }
};

struct EpiDft {
    bf16_t* pq; const bf16_t* ft; int lng;
    __device__ __forceinline__ void operator()(const f32x4 (&acc)[2][2][4][2], const Unit& u, int wr, int wc, int fr, int fq, LAS unsigned char* xs, int wid, int lane) const {
        const int S = lng ? 4096 : 2048, hp = lng ? 8 : 4;
        const int cs = u.pm >= hp, k0 = (u.pm - hp * cs) * 256 + wr * 64;
        const size_t tok0 = lng ? (size_t)TP + (size_t)u.aux * 4096 : (size_t)u.aux * 2048;
        const float sc = lng ? 0.015625f : 0.02209708691207961f;
        const float scm = cs ? -sc : sc;
        float hv[2][8];
        const float csm = cs ? 0.f : 1.f;
#pragma unroll
        for (int bj = 0; bj < 2; ++bj)
#pragma unroll
            for (int e = 0; e < 8; ++e) {
                const unsigned short h = ft[(size_t)(u.pn * 256 + bj * 128 + wc * 32 + 8 * fq + e) * T + tok0 + S / 2];
                const float v = __builtin_bit_cast(float, (unsigned)h << 16) * csm;
                hv[bj][e] = (fr & 1) ? -v : v;
            }
#pragma unroll
        for (int ai = 0; ai < 2; ++ai)
#pragma unroll
            for (int m = 0; m < 4; ++m) {
                const int k = k0 + ai * 128 + m * 16 + fr;
#pragma unroll
                for (int bj = 0; bj < 2; ++bj) {
                    const int col = (2 * u.pn + bj) * 256 + cs * 128 + wc * 32 + 8 * fq;
                    f32x4 a = acc[ai][bj][m][0], b = acc[ai][bj][m][1];
#pragma unroll
                    for (int j = 0; j < 4; ++j) { a[j] += hv[bj][j]; b[j] += hv[bj][4 + j]; }
                    u32x4 w; w.x = cvt_pk_bf16(a[0] * sc, a[1] * sc); w.y = cvt_pk_bf16(a[2] * sc, a[3] * sc); w.z = cvt_pk_bf16(b[0] * sc, b[1] * sc); w.w = cvt_pk_bf16(b[2] * sc, b[3] * sc);
                    *(u32x4*)(pq + (tok0 + k) * 1024 + col) = w;
                    if (k > 0) {
                        u32x4 w2; w2.x = cvt_pk_bf16(a[0] * scm, a[1] * scm); w2.y = cvt_pk_bf16(a[2] * scm, a[3] * scm); w2.z = cvt_pk_bf16(b[0] * scm, b[1] * scm); w2.w = cvt_pk_bf16(b[2] * scm, b[3] * scm);
                        *(u32x4*)(pq + (tok0 + S - k) * 1024 + col) = w2;
                    }
                }
                __builtin_amdgcn_sched_barrier(0);
            }
    }
};

__device__ __forceinline__ int map_even(int n) {
    if (n < 1536) return n;
    if (n < 2048) return 4608 + (n - 1536);
    if (n < 2560) return 1536 + (n - 2048);
    if (n < 4096) return 3072 + (n - 2560);
    if (n < 4608) return 2048 + (n - 4096);
    return 2560 + (n - 4608);
}
__device__ __forceinline__ int map_odd(int n) {
    const int pn = n >> 8, half = (n >> 7) & 1, off = n & 127;
    if (pn < 8) return (half ? 2048 : 0) + 128 * pn + off;
    if (pn < 16) return (half ? 3072 : 1024) + 128 * (pn - 8) + off;
    if (pn < 24) return (half ? 6144 : 4096) + 128 * (pn - 16) + off;
    return 5120 + (n - 6144);
}
template <int MODE>
__device__ __forceinline__ void wconv(const float* W, int N, bf16_t* WT, const float* gain, LAS float* scr, int gw, int NGW, int lane) {
    const int nblk = N / 64, nitems = 32 * nblk;
    for (int item = gw; item < nitems; item += NGW) {
        const int kb = item / nblk, nb = item % nblk, k0 = 64 * kb, n0 = 64 * nb;
        const int s0 = MODE == 0 ? n0 : (MODE == 1 ? map_even(n0) : map_odd(n0));
        const int kr = lane >> 4, n4 = (lane & 15) * 4;
        f32x4 v[16];
#pragma unroll
        for (int i = 0; i < 16; ++i) v[i] = *(const f32x4*)(W + (size_t)(k0 + 4 * i + kr) * N + s0 + n4);
#pragma unroll
        for (int i = 0; i < 16; ++i) { const int kk = 4 * i + kr; const float g = gain ? gain[k0 + kk] : 1.f; LAS float* d = scr + kk * 65 + n4; d[0] = v[i][0] * g; d[1] = v[i][1] * g; d[2] = v[i][2] * g; d[3] = v[i][3] * g; }
        LDS_WAIT();
        const int c = lane & 7;
#pragma unroll
        for (int j = 0; j < 8; ++j) { const int n = (lane >> 3) + 8 * j; const LAS float* sp = scr + (8 * c) * 65 + n;
            u32x4 o; o.x = cvt_pk_bf16(sp[0 * 65], sp[1 * 65]); o.y = cvt_pk_bf16(sp[2 * 65], sp[3 * 65]); o.z = cvt_pk_bf16(sp[4 * 65], sp[5 * 65]); o.w = cvt_pk_bf16(sp[6 * 65], sp[7 * 65]);
            *(u32x4*)(WT + (size_t)(n0 + n) * 2048 + k0 + 8 * c) = o; }
        LDS_WAIT();
    }
}

__device__ __forceinline__ int t5_bucket(int rel) {
    const int n = rel < 0 ? -rel : rel;
    const int b = n < 8 ? n : 8 + (n >= 12) + (n >= 16) + (n >= 23) + (n >= 32) + (n >= 46) + (n >= 64) + (n >= 91);
    return (rel > 0 ? 16 : 0) + b;
}

__device__ __forceinline__ void attn_phase(const Params& p, LAS unsigned char* lds, int li, int tid, int G, bf16_t* __restrict__ dst, const bf16_t* __restrict__ ZGA) {
    asm volatile("" : "+v"(tid));
    unsigned char* ws = p.ws;
    const int w = __builtin_amdgcn_readfirstlane(tid >> 6);
    LAS float* BS = (LAS float*)(lds + 131072 + 1024);
    const bf16_t* Z0 = (const bf16_t*)(ws + OFF_Z0);
    const bf16_t* ZK = (const bf16_t*)(ws + OFF_ZK); const bf16_t* ZVT = (const bf16_t*)(ws + OFF_ZVT);
    auto dma_stage = [&](int item, int kb, int buf) {
        int l = tid & 63; asm volatile("" : "+v"(l));
        const int tb = item >> 2, hk = item & 3, tk = tb * 128 + (kb - 1) * 128;
        LAS unsigned char* kl = lds + buf * 65536; LAS unsigned char* vl = kl + 32768;
#pragma unroll
        for (int i = 0; i < 4; ++i) {
            const int r = 4 * (4 * w + i) + (l >> 4), c = (l & 15) ^ (r & 15);
            __builtin_amdgcn_global_load_lds((const unsigned*)(ZK + (size_t)(tk + r) * 512 + hk * 128 + c * 8), (LAS unsigned*)(kl + (4 * w + i) * 1024), 16, 0, 0);
            __builtin_amdgcn_global_load_lds((const unsigned*)(ZVT + (size_t)(hk * 128 + r) * T + tk + c * 8), (LAS unsigned*)(vl + (4 * w + i) * 1024), 16, 0, 0);
        }
    };
    int buf = 0, curhk = -1;
    int ibase, istep, icnt;
    if (G & 7) { ibase = blockIdx.x; istep = G; icnt = ibase < 1024 ? (1024 - ibase + G - 1) / G : 0; }
    else { const int nper = G >> 3, j0 = blockIdx.x >> 3; ibase = (blockIdx.x & 7) * 128 + j0; istep = nper; icnt = j0 < 128 ? (128 - j0 + nper - 1) / nper : 0; }
    u32x4 qraw[3][4];
    auto load_q = [&](int item, int lq_, int g_) {
        const int tb = item >> 2, hk = item & 3;
#pragma unroll
        for (int mb = 0; mb < 3; ++mb) {
            const int hh = mb, r = 16 * w + lq_;
            const bf16_t* qp = Z0 + (size_t)(tb * 128 + r) * 2048 + (3 * hk + hh) * 128 + 8 * g_;
#pragma unroll
            for (int ks = 0; ks < 4; ++ks) qraw[mb][ks] = *(const u32x4*)(qp + 32 * ks);
        }
    };
    if (icnt > 0) { dma_stage(ibase, 1, 0); load_q(ibase, tid & 15, (tid & 63) >> 4); }
    for (int kround = 0; kround < icnt; ++kround) {
        const int item = ibase + kround * istep;
        const int nitem = (kround + 1 < icnt) ? item + istep : -1;
        int l = tid & 63; asm volatile("" : "+v"(l));
        const int lq = l & 15, g = l >> 4;
        const int tb = item >> 2, hk = item & 3;
        const int nblk = tb < 128 ? 16 : 32, nbi = tb < 128 ? (tb & 15) : ((tb - 128) & 31);
        const int t0 = tb * 128;
        const bool has0 = nbi > 0, has2 = nbi < nblk - 1;
        const int nkb = 1 + (has0 ? 1 : 0) + (has2 ? 1 : 0);
        if (hk != curhk) {
            __syncthreads();
            const float* bt = (const float*)(ws + OFF_BIAS) + (size_t)(li * 12 + 3 * hk) * 260; for (int i = 64 * w + l; i < 3 * 260; i += 512) BS[i] = bt[i];
            curhk = hk;
        }
        bf16x8 Qf[3][4];
        {
            const float* qg = p.q_gain + li * 128; const float* kg = p.k_gain + li * 128;
#pragma unroll
            for (int mb = 0; mb < 3; ++mb) {
                u32x4 raw[4]; float ss = 0.f;
#pragma unroll
                for (int ks = 0; ks < 4; ++ks) { raw[ks] = qraw[mb][ks];
#pragma unroll
                    for (int e = 0; e < 4; ++e) { const float a = bf_lo(raw[ks][e]), b = bf_hi(raw[ks][e]); ss += a * a + b * b; } }
                ss += __shfl_xor(ss, 16); ss += __shfl_xor(ss, 32);
                const float rq = rsqrtf(ss * (1.f / 128.f) + EPS) * (0.08838834764831845f * LOG2E);
#pragma unroll
                for (int ks = 0; ks < 4; ++ks) {
                    const f32x4 g0 = *(const f32x4*)(qg + 32 * ks + 8 * g) * *(const f32x4*)(kg + 32 * ks + 8 * g), g1 = *(const f32x4*)(qg + 32 * ks + 8 * g + 4) * *(const f32x4*)(kg + 32 * ks + 8 * g + 4);
                    u32x4 o;
                    o.x = cvt_pk_bf16(bf_lo(raw[ks].x) * rq * g0[0], bf_hi(raw[ks].x) * rq * g0[1]);
                    o.y = cvt_pk_bf16(bf_lo(raw[ks].y) * rq * g0[2], bf_hi(raw[ks].y) * rq * g0[3]);
                    o.z = cvt_pk_bf16(bf_lo(raw[ks].z) * rq * g1[0], bf_hi(raw[ks].z) * rq * g1[1]);
                    o.w = cvt_pk_bf16(bf_lo(raw[ks].w) * rq * g1[2], bf_hi(raw[ks].w) * rq * g1[3]);
                    Qf[mb][ks] = __builtin_bit_cast(bf16x8, o);
                }
            }
        }
        f32x4 oacc[3][8];
        float lrun[3];
#pragma unroll
        for (int mb = 0; mb < 3; ++mb) {
            lrun[mb] = 0.f;
#pragma unroll
            for (int db = 0; db < 8; ++db) oacc[mb][db] = (f32x4){0.f, 0.f, 0.f, 0.f};
        }
#pragma unroll 1
        for (int step = 0; step < nkb; ++step) {
            const int kb = (step == 0) ? 1 : ((step == 1 && has0) ? 0 : 2);
            asm volatile("s_waitcnt vmcnt(0)" ::: "memory");
            __syncthreads();
            if (step + 1 < nkb) dma_stage(item, (step == 0 && has0) ? 0 : 2, buf ^ 1);
            else if (nitem >= 0) dma_stage(nitem, 1, buf ^ 1);
            LAS unsigned char* KS = lds + buf * 65536; LAS unsigned char* VS = KS + 32768;
            {
                const int key = 16 * w + (l >> 2), part = l & 3;
                u32x4 v[4]; float ss = 0.f;
#pragma unroll
                for (int i = 0; i < 4; ++i) { v[i] = *(const LAS u32x4*)(KS + key * 256 + (((4 * part + i) ^ (key & 15)) << 4));
#pragma unroll
                    for (int e = 0; e < 4; ++e) { const float a = bf_lo(v[i][e]), b = bf_hi(v[i][e]); ss += a * a + b * b; } }
                ss += __shfl_xor(ss, 1); ss += __shfl_xor(ss, 2);
                const float rk = rsqrtf(ss * (1.f / 128.f) + EPS);
#pragma unroll
                for (int i = 0; i < 4; ++i) { u32x4 o;
#pragma unroll
                    for (int e = 0; e < 4; ++e) o[e] = cvt_pk_bf16(bf_lo(v[i][e]) * rk, bf_hi(v[i][e]) * rk);
                    *(LAS u32x4*)(KS + key * 256 + (((4 * part + i) ^ (key & 15)) << 4)) = o; }
            }
            __syncthreads();
#pragma unroll 1
            for (int qt = 0; qt < 4; ++qt) {
                if ((kb == 0) ? (32 * qt + 31 < 16 * w) : ((kb == 2) ? (32 * qt > 16 * w + 15) : false)) continue;
                const bool nomask = (kb == 1) || ((kb == 0) ? (32 * qt >= 16 * w + 15) : (32 * qt + 31 <= 16 * w));
                f32x4 sacc[3][2];
#pragma unroll
                for (int mb = 0; mb < 3; ++mb) { sacc[mb][0] = (f32x4){0.f, 0.f, 0.f, 0.f}; sacc[mb][1] = (f32x4){0.f, 0.f, 0.f, 0.f}; }
#pragma unroll
                for (int ks = 0; ks < 4; ++ks)
#pragma unroll
                    for (int n = 0; n < 2; ++n) {
                        const bf16x8 Kf = *(const LAS bf16x8*)(KS + (32 * qt + 16 * n + lq) * 256 + (((4 * ks + g) ^ lq) << 4));
#pragma unroll
                        for (int mb = 0; mb < 3; ++mb) sacc[mb][n] = __builtin_amdgcn_mfma_f32_16x16x32_bf16(Kf, Qf[mb][ks], sacc[mb][n], 0, 0, 0);
                    }
                bf16x8 Pf[3];
#pragma unroll
                for (int mb = 0; mb < 3; ++mb) {
                    const int hh = mb, r = 16 * w + lq;
                    u32x4 o = {0u, 0u, 0u, 0u};
                    {
                        const int ib = 128 * kb - r + 32 * qt + 4 * g;
                        const LAS float* bh = BS + hh * 260;
                        float ls = 0.f; float pe[2][4];
                        if (nomask) {
#pragma unroll
                            for (int n = 0; n < 2; ++n)
#pragma unroll
                                for (int j = 0; j < 4; ++j) { const float e = __builtin_amdgcn_exp2f(sacc[mb][n][j] + bh[ib + 16 * n + j]); pe[n][j] = e; ls += e; }
                        } else {
#pragma unroll
                            for (int n = 0; n < 2; ++n)
#pragma unroll
                                for (int j = 0; j < 4; ++j) {
                                    const int idx = ib + 16 * n + j, ic = min(max(idx, 0), 256);
                                    const float e = __builtin_amdgcn_exp2f(sacc[mb][n][j] + bh[ic]);
                                    const float pv = (idx == ic) ? e : 0.f; pe[n][j] = pv; ls += pv;
                                }
                        }
                        lrun[mb] += ls;
                        o.x = cvt_pk_bf16(pe[0][0], pe[0][1]); o.y = cvt_pk_bf16(pe[0][2], pe[0][3]); o.z = cvt_pk_bf16(pe[1][0], pe[1][1]); o.w = cvt_pk_bf16(pe[1][2], pe[1][3]);
                    }
                    Pf[mb] = __builtin_bit_cast(bf16x8, o);
                }
#pragma unroll
                for (int db = 0; db < 8; ++db) {
                    const LAS unsigned char* vrow = VS + (16 * db + lq) * 256 + (g & 1) * 8;
                    const u32x2 lo = *(const LAS u32x2*)(vrow + (((4 * qt + (g >> 1)) ^ lq) << 4)), hi = *(const LAS u32x2*)(vrow + (((4 * qt + 2 + (g >> 1)) ^ lq) << 4));
                    u32x4 vv; vv.x = lo.x; vv.y = lo.y; vv.z = hi.x; vv.w = hi.y;
                    const bf16x8 Vf = __builtin_bit_cast(bf16x8, vv);
#pragma unroll
                    for (int mb = 0; mb < 3; ++mb) oacc[mb][db] = __builtin_amdgcn_mfma_f32_16x16x32_bf16(Vf, Pf[mb], oacc[mb][db], 0, 0, 0);
                }
            }
            buf ^= 1;
        }
        u32x2 gv[3][8];
#pragma unroll
        for (int mb = 0; mb < 3; ++mb) {
            const int hh = mb, r = 16 * w + lq;
            const bf16_t* gp = ZGA + (size_t)(t0 + r) * 1536 + (3 * hk + hh) * 128 + 4 * g;
#pragma unroll
            for (int db = 0; db < 8; ++db) gv[mb][db] = *(const u32x2*)(gp + 16 * db);
        }
        load_q(nitem >= 0 ? nitem : item, lq, g);
#pragma unroll
        for (int mb = 0; mb < 3; ++mb) {
            const int hh = mb, r = 16 * w + lq;
            const size_t tok = (size_t)(t0 + r); const int hcol = (3 * hk + hh) * 128 + 4 * g;
            float lt = lrun[mb]; lt += __shfl_xor(lt, 16); lt += __shfl_xor(lt, 32);
            lt += __builtin_amdgcn_exp2f(BS[hh * 260 + 257]);
            const float inv = 1.f / lt;
#pragma unroll
            for (int db = 0; db < 8; ++db) {
                const f32x4 o = oacc[mb][db] * inv;
                u32x2 wv; wv.x = cvt_pk_bf16(o[0] * silu_f(bf_lo(gv[mb][db].x)), o[1] * silu_f(bf_hi(gv[mb][db].x))); wv.y = cvt_pk_bf16(o[2] * silu_f(bf_lo(gv[mb][db].y)), o[3] * silu_f(bf_hi(gv[mb][db].y)));
                *(u32x2*)(dst + tok * 2048 + hcol + 16 * db) = wv;
            }
        }
    }
    asm volatile("s_waitcnt vmcnt(0)" ::: "memory");
    __syncthreads();
}

__device__ __forceinline__ void chanmix_phase(const Params& p, LAS unsigned char* lds, int li, int tid, int G, bf16_t* dst) {
    asm volatile("" : "+v"(tid));
    unsigned char* ws = p.ws;
    const int w = tid >> 6, l = tid & 63, lq = l & 15, g4 = l >> 4;
    const bf16_t* PQ = (const bf16_t*)((unsigned char*)p.out + DO_PQ); bf16_t* Z0 = (bf16_t*)(ws + OFF_Z0);
    int curg = -1;
    bf16x8 Bf[8]; u32x2 gv[8];
    int item = blockIdx.x;
    if (item < 1024) {
        const int tb = item >> 2, g = item & 3; const size_t tok = (size_t)(tb * 128 + 16 * w + lq);
#pragma unroll
        for (int ks = 0; ks < 8; ++ks) Bf[ks] = *(const bf16x8*)(PQ + tok * 1024 + g * 256 + 32 * ks + 8 * g4);
#pragma unroll
        for (int db = 0; db < 8; ++db) gv[db] = *(const u32x2*)(Z0 + tok * 2048 + 1536 + g * 128 + 16 * db + 4 * g4);
    }
    for (; item < 1024; item += G) {
        const int tb = item >> 2, g = item & 3, t0 = tb * 128;
        if (g != curg) {
            __syncthreads();
            const bf16_t* W2 = (const bf16_t*)(ws + OFF_W2) + (size_t)(li * 4 + g) * 128 * 256;
            for (int q = tid; q < 4096; q += 512) { const int row = q >> 5, c16 = q & 31; *(LAS u32x4*)(lds + row * 528 + c16 * 16) = *(const u32x4*)(W2 + row * 256 + c16 * 8); }
            __syncthreads();
            curg = g;
        }
        const size_t tok = (size_t)(t0 + 16 * w + lq);
        f32x4 acc[8];
#pragma unroll
        for (int db = 0; db < 8; ++db) { acc[db] = (f32x4){0.f, 0.f, 0.f, 0.f};
#pragma unroll
            for (int ks = 0; ks < 8; ++ks) { const bf16x8 Af = *(const LAS bf16x8*)(lds + (16 * db + lq) * 528 + (32 * ks + 8 * g4) * 2); acc[db] = __builtin_amdgcn_mfma_f32_16x16x32_bf16(Af, Bf[ks], acc[db], 0, 0, 0); } }
        u32x2 gc[8];
#pragma unroll
        for (int db = 0; db < 8; ++db) gc[db] = gv[db];
        const int nitem = item + G;
        if (nitem < 1024) {
            const int tb2 = nitem >> 2, g2 = nitem & 3; const size_t tok2 = (size_t)(tb2 * 128 + 16 * w + lq);
#pragma unroll
            for (int ks = 0; ks < 8; ++ks) Bf[ks] = *(const bf16x8*)(PQ + tok2 * 1024 + g2 * 256 + 32 * ks + 8 * g4);
#pragma unroll
            for (int db = 0; db < 8; ++db) gv[db] = *(const u32x2*)(Z0 + tok2 * 2048 + 1536 + g2 * 128 + 16 * db + 4 * g4);
        }
        const float* bf = p.b_f + (li * 4 + g) * 128;
        f32x4 bv[8];
#pragma unroll
        for (int db = 0; db < 8; ++db) bv[db] = *(const f32x4*)(bf + 16 * db + 4 * g4);
#pragma unroll
        for (int db = 0; db < 8; ++db) {
            const int d = 16 * db + 4 * g4;
            bf16_t* zp = dst + tok * 2048 + 1536 + g * 128 + d;
            const f32x4 b = bv[db];
            u32x2 o; o.x = cvt_pk_bf16((acc[db][0] + b[0]) * silu_f(bf_lo(gc[db].x)), (acc[db][1] + b[1]) * silu_f(bf_hi(gc[db].x)));
            o.y = cvt_pk_bf16((acc[db][2] + b[2]) * silu_f(bf_lo(gc[db].y)), (acc[db][3] + b[3]) * silu_f(bf_hi(gc[db].y)));
            *(u32x2*)zp = o;
        }
    }
}

__device__ __forceinline__ void conv_phase(const Params& p, int li, int tid, int NGW, bf16_t* dst) {
    asm volatile("" : "+v"(tid));
    unsigned char* ws = p.ws;
    const int lane = tid & 63, gw = blockIdx.x * 8 + (tid >> 6);
    const bf16_t* ZM = (const bf16_t*)(ws + OFF_ZM); bf16_t* Z0 = (bf16_t*)(ws + OFF_Z0);
    const float* cw = p.conv_w + (size_t)li * 3 * 1024;
    for (int job = gw; job < 2048; job += NGW) {
        const int seg = job >> 1, c8 = (job & 1) * 512 + lane * 8, t0 = seg * 32;
        const int S = t0 < TP ? 2048 : 4096, s0 = t0 & (S - 1);
        float w0[8], w1[8], w2[8];
#pragma unroll
        for (int e = 0; e < 2; ++e) { const f32x4 a = *(const f32x4*)(cw + c8 + 4 * e), b = *(const f32x4*)(cw + 1024 + c8 + 4 * e), c = *(const f32x4*)(cw + 2048 + c8 + 4 * e);
#pragma unroll
            for (int j = 0; j < 4; ++j) { w0[4 * e + j] = a[j]; w1[4 * e + j] = b[j]; w2[4 * e + j] = c[j]; } }
        const u32x4 z = {0u, 0u, 0u, 0u};
        u32x4 mp = (s0 > 0) ? *(const u32x4*)(ZM + (size_t)(t0 - 1) * 1024 + c8) : z;
        u32x4 mc = *(const u32x4*)(ZM + (size_t)t0 * 1024 + c8);
#pragma unroll 1
        for (int ch = 0; ch < 4; ++ch) {
            u32x4 mn[8], bb[8];
#pragma unroll
            for (int i = 0; i < 8; ++i) { const int t = t0 + ch * 8 + i;
                mn[i] = (s0 + ch * 8 + i < S - 1) ? *(const u32x4*)(ZM + (size_t)(t + 1) * 1024 + c8) : z;
                bb[i] = *(const u32x4*)(Z0 + (size_t)t * 2048 + c8); }
#pragma unroll
            for (int i = 0; i < 8; ++i) {
                u32x4 o;
#pragma unroll
                for (int e = 0; e < 4; ++e) {
                    const float lo = bf_lo(bb[i][e]) * (w0[2 * e] * bf_lo(mp[e]) + w1[2 * e] * bf_lo(mc[e]) + w2[2 * e] * bf_lo(mn[i][e]));
                    const float hi = bf_hi(bb[i][e]) * (w0[2 * e + 1] * bf_hi(mp[e]) + w1[2 * e + 1] * bf_hi(mc[e]) + w2[2 * e + 1] * bf_hi(mn[i][e]));
                    o[e] = cvt_pk_bf16(lo, hi);
                }
                *(u32x4*)(dst + (size_t)(t0 + ch * 8 + i) * 2048 + c8) = o;
                mp = mc; mc = mn[i];
            }
        }
    }
}
__device__ __forceinline__ void sgu_phase(const Params& p, LAS unsigned char* lds, int li, int tid, int G, bf16_t* dst) {
    asm volatile("" : "+v"(tid));
    unsigned char* ws = p.ws;
    const int w = tid >> 6, l = tid & 63, lq = l & 15, g4 = l >> 4;
    const bf16_t* ZVT = (const bf16_t*)(ws + OFF_ZVT2); bf16_t* Z0 = (bf16_t*)(ws + OFF_Z0);
    const float* vss = (const float*)(ws + OFF_VSS);
    LAS float* RI = (LAS float*)(lds + 34816);
    const int c = tid >> 2, q0 = (tid & 3) * 32;
    u32x4 raw[4]; f32x4 vs = {1.f, 1.f, 1.f, 1.f};
    int item = blockIdx.x;
    if (item < 2048) {
        const int tb = item >> 3, g = item & 7, t0 = tb * 128;
#pragma unroll
        for (int i = 0; i < 4; ++i) raw[i] = *(const u32x4*)(ZVT + (size_t)(g * 128 + c) * T + t0 + q0 + 8 * i);
        if (tid < 128) vs = *(const f32x4*)(vss + (size_t)(t0 + tid) * 32 + g * 4);
    }
    for (; item < 2048; item += G) {
        const int tb = item >> 3, g = item & 7, t0 = tb * 128;
        __syncthreads();
        if (tid < 128) RI[tid] = rsqrtf(((vs[0] + vs[1]) + (vs[2] + vs[3])) * (1.f / 128.f) + EPS);
        const size_t tok = (size_t)(t0 + 16 * w + lq);
        const bf16_t* WS = (const bf16_t*)(ws + OFF_WSB) + (size_t)(li * 8 + g) * 128 * 128;
        bf16x8 Wf[4]; u32x2 uv[8];
#pragma unroll
        for (int ks = 0; ks < 4; ++ks) Wf[ks] = *(const bf16x8*)(WS + (16 * w + lq) * 128 + 32 * ks + 8 * g4);
#pragma unroll
        for (int cb = 0; cb < 8; ++cb) uv[cb] = *(const u32x2*)(Z0 + tok * 2048 + 1024 + g * 128 + 16 * cb + 4 * g4);
        __syncthreads();
#pragma unroll
        for (int i = 0; i < 4; ++i) {
            const LAS float* ri = RI + q0 + 8 * i;
            u32x4 o;
            o.x = cvt_pk_bf16(bf_lo(raw[i].x) * ri[0], bf_hi(raw[i].x) * ri[1]); o.y = cvt_pk_bf16(bf_lo(raw[i].y) * ri[2], bf_hi(raw[i].y) * ri[3]);
            o.z = cvt_pk_bf16(bf_lo(raw[i].z) * ri[4], bf_hi(raw[i].z) * ri[5]); o.w = cvt_pk_bf16(bf_lo(raw[i].w) * ri[6], bf_hi(raw[i].w) * ri[7]);
            *(LAS u32x4*)(lds + c * 272 + q0 * 2 + 16 * i) = o;
        }
        const int nitem = item + G;
        if (nitem < 2048) {
            const int tb2 = nitem >> 3, g2 = nitem & 7, t2 = tb2 * 128;
#pragma unroll
            for (int i = 0; i < 4; ++i) raw[i] = *(const u32x4*)(ZVT + (size_t)(g2 * 128 + c) * T + t2 + q0 + 8 * i);
            if (tid < 128) vs = *(const f32x4*)(vss + (size_t)(t2 + tid) * 32 + g2 * 4);
        }
        __syncthreads();
        f32x4 acc[8];
#pragma unroll
        for (int cb = 0; cb < 8; ++cb) { acc[cb] = (f32x4){0.f, 0.f, 0.f, 0.f};
#pragma unroll
            for (int ks = 0; ks < 4; ++ks) { const bf16x8 Af = *(const LAS bf16x8*)(lds + (16 * cb + lq) * 272 + (32 * ks + 8 * g4) * 2); acc[cb] = __builtin_amdgcn_mfma_f32_16x16x32_bf16(Af, Wf[ks], acc[cb], 0, 0, 0); } }
        const float bs = p.b_s[(li * 8 + g) * 128 + 16 * w + lq];
        const float* vg = p.v_gain + li * 1024 + g * 128;
        f32x4 gnv[8];
#pragma unroll
        for (int cb = 0; cb < 8; ++cb) gnv[cb] = *(const f32x4*)(vg + 16 * cb + 4 * g4);
#pragma unroll
        for (int cb = 0; cb < 8; ++cb) {
            const int cc = 16 * cb + 4 * g4;
            bf16_t* zp = dst + tok * 2048 + 1024 + g * 128 + cc;
            const f32x4 gn = gnv[cb];
            u32x2 o; o.x = cvt_pk_bf16(bf_lo(uv[cb].x) * (acc[cb][0] * gn[0] + bs), bf_hi(uv[cb].x) * (acc[cb][1] * gn[1] + bs));
            o.y = cvt_pk_bf16(bf_lo(uv[cb].y) * (acc[cb][2] * gn[2] + bs), bf_hi(uv[cb].y) * (acc[cb][3] * gn[3] + bs));
            *(u32x2*)zp = o;
        }
    }
}

#define XB_TMO      128
#define XB_XCNT(j)  (256  + 64 * (j))
#define XB_XSUB(j)  (1280 + 64 * (j))
#define XB_XGEN(j)  (2304 + 64 * (j))
#define XB_TOP      3328
#define XB_TOPGEN   3392
#define XCD_BAR_WORDS 3456
#define XB_SPIN_CAP (1u << 18)
__device__ __forceinline__ unsigned xb_ld(unsigned* p)              { return __hip_atomic_load(p, __ATOMIC_RELAXED, __HIP_MEMORY_SCOPE_AGENT); }
__device__ __forceinline__ unsigned xb_add(unsigned* p, unsigned v) { return __hip_atomic_fetch_add(p, v, __ATOMIC_RELAXED, __HIP_MEMORY_SCOPE_AGENT); }
__device__ __forceinline__ unsigned xb_xcc_id() { return (unsigned)__builtin_amdgcn_s_getreg((3 << 11) | 20) & 0xFu; }
#define XB_SPIN(cond, bar) do { unsigned _sp = 0; while (cond) { __builtin_amdgcn_s_sleep(1); \
    if ((++_sp & 255u) == 0u) { if (xb_ld(&(bar)[XB_TMO])) break; if (_sp > XB_SPIN_CAP) { atomicAdd(&(bar)[XB_TMO], 1u); break; } } } } while (0)
struct XcdBarrier { unsigned* bar; unsigned x, nloc, nx; };
__device__ __forceinline__ void xcd_barrier(const XcdBarrier& b) {
    asm volatile("s_waitcnt vmcnt(0)" ::: "memory");
    __syncthreads();
    if (threadIdx.x == 0) {
        unsigned* bar = b.bar;
        __builtin_amdgcn_s_waitcnt(0);
        const unsigned nloc = b.nloc, nx = b.nx;
        const unsigned old = xb_add(&bar[XB_XSUB(b.x)], 1u);
        const unsigned gen = old / nloc;
        if (old + 1u == (gen + 1u) * nloc) {
            __builtin_amdgcn_fence(__ATOMIC_RELEASE, "agent");
            asm volatile("s_waitcnt vmcnt(0)" ::: "memory");
            const unsigned og = xb_add(&bar[XB_TOP], 1u);
            const unsigned tg = og / nx;
            if (og + 1u == (tg + 1u) * nx) xb_add(&bar[XB_TOPGEN], 1u);
            else XB_SPIN(xb_ld(&bar[XB_TOPGEN]) == tg, bar);
            __builtin_amdgcn_fence(__ATOMIC_ACQUIRE, "agent");
            xb_add(&bar[XB_XGEN(b.x)], 1u);
            asm volatile("s_waitcnt vmcnt(0)" ::: "memory");
        } else {
            XB_SPIN(xb_ld(&bar[XB_XGEN(b.x)]) == gen, bar);
            __builtin_amdgcn_fence(__ATOMIC_ACQUIRE, "agent");
            asm volatile("s_waitcnt vmcnt(0)" ::: "memory");
        }
    }
    __syncthreads();
}

typedef const Params __attribute__((address_space(4)))* KParamsPtr;
__device__ __forceinline__ Params load_params() {
#if defined(__HIP_DEVICE_COMPILE__)
    KParamsPtr k = (KParamsPtr)__builtin_amdgcn_kernarg_segment_ptr(); asm volatile("" : "+s"(k));
    Params r;
    r.x_prompt = k->x_prompt; r.x_sample = k->x_sample; r.norm_gain = k->norm_gain; r.rel_bias = k->rel_bias; r.w_in_e = k->w_in_e; r.w_out_e = k->w_out_e; r.q_gain = k->q_gain; r.k_gain = k->k_gain;
    r.sink = k->sink; r.w_f = k->w_f; r.b_f = k->b_f; r.w_in_o = k->w_in_o; r.conv_w = k->conv_w; r.v_gain = k->v_gain; r.w_s = k->w_s; r.b_s = k->b_s; r.w_out_o = k->w_out_o; r.out = k->out; r.ws = k->ws;
    return r;
#else
    return Params{};
#endif
}
#define PP load_params()
#define FRESH_IDS() int tid = threadIdx.x; asm volatile("" : "+v"(tid)); const int lane = tid & 63, wave = tid >> 6; \
    const int gw = blockIdx.x * 8 + wave, gtid = blockIdx.x * 512 + tid; LAS float* scr = (LAS float*)(lds + wave * 16896); (void)lane; (void)gw; (void)gtid; (void)scr;

template <int layer>
__device__ __forceinline__ void run_layer(LAS unsigned char* lds, const XcdBarrier& xb) {
    unsigned char* ws = PP.ws;
    const int G = gridDim.x, NGW = G * 8, NT = G * 512;
    bf16_t* XB = (bf16_t*)(ws + OFF_XB); float* RSS = (float*)(ws + OFF_RSS);
    bf16_t* WIN = (bf16_t*)(ws + OFF_WIN); bf16_t* WOUT = (bf16_t*)(ws + OFF_WOUT);
    (void)NGW; (void)NT; (void)XB; (void)RSS; (void)WIN; (void)WOUT;

        const int li = layer >> 1;
        const bool last_layer = (layer == 3);
        if ((layer & 1) == 0) {
            if (layer > 0) { FRESH_IDS(); wconv<0>(PP.w_out_e + (size_t)li * 2048 * 2048, 2048, WOUT, nullptr, scr, gw, NGW, lane); }
            __syncthreads();

            { pg8::GemmSched S; S.init(T, 5120, G, blockIdx.x, XB, 2048, WIN, 2048); EpiIn<false> E{RSS, ws}; pg8::gemm_phase(lds, 2048, 2048, 2048, S, E); }
            xcd_barrier(xb);
            { FRESH_IDS();
            wconv<2>(PP.w_in_o + (size_t)li * 2048 * 7168, 7168, WIN, PP.norm_gain + (layer + 1) * D, scr, gw, NGW, lane);
            {
                const bf16_t* FT = (const bf16_t*)(ws + OFF_ZFT);
                bf16_t* FE = (bf16_t*)((unsigned char*)PP.out + DO_FE); bf16_t* FO = (bf16_t*)((unsigned char*)PP.out + DO_FO);
                constexpr int NFOLD = 512 * (T / 16);
                for (int i0 = gtid; i0 < NFOLD; i0 += 4 * NT) {
                    u32x4 own[4], mir[4]; unsigned short m0[4]; int s8v[4]; size_t dsto[4];
#pragma unroll
                    for (int u = 0; u < 4; ++u) {
                        const int i = min(i0 + u * NT, NFOLD - 1);
                        const int ch = i >> 11, h8 = (i & 2047) * 8;
                        int S, tok0, s8;
                        if (h8 < TP / 2) { S = 2048; tok0 = (h8 >> 10) * 2048; s8 = h8 & 1023; } else { S = 4096; const int q = h8 - TP / 2; tok0 = TP + (q >> 11) * 4096; s8 = q & 2047; }
                        const bf16_t* fp = FT + (size_t)ch * T + tok0;
                        own[u] = *(const u32x4*)(fp + s8);
                        mir[u] = *(const u32x4*)(fp + S - s8 - 8);
                        m0[u] = fp[s8 > 0 ? S - s8 : 0];
                        s8v[u] = s8; dsto[u] = (size_t)ch * (T / 2) + h8;
                    }
#pragma unroll
                    for (int u = 0; u < 4; ++u) {
                        if (i0 + u * NT < NFOLD) {
                            float a[8], b[8];
#pragma unroll
                            for (int e = 0; e < 4; ++e) { a[2 * e] = bf_lo(own[u][e]); a[2 * e + 1] = bf_hi(own[u][e]); }
                            b[0] = __builtin_bit_cast(float, (unsigned)m0[u] << 16);
#pragma unroll
                            for (int e = 1; e < 8; ++e) { const int q = 8 - e; b[e] = (q & 1) ? bf_hi(mir[u][q >> 1]) : bf_lo(mir[u][q >> 1]); }
                            float fe[8], fo[8];
#pragma unroll
                            for (int e = 0; e < 8; ++e) { fe[e] = a[e] + b[e]; fo[e] = a[e] - b[e]; }
                            if (s8v[u] == 0) { fe[0] = a[0]; fo[0] = 0.f; }
                            u32x4 oe, oo;
#pragma unroll
                            for (int e = 0; e < 4; ++e) { oe[e] = cvt_pk_bf16(fe[2 * e], fe[2 * e + 1]); oo[e] = cvt_pk_bf16(fo[2 * e], fo[2 * e + 1]); }
                            *(u32x4*)(FE + dsto[u]) = oe; *(u32x4*)(FO + dsto[u]) = oo;
                        }
                    }
                }
            }
            }
            __syncthreads();

            attn_phase(PP, lds, li, threadIdx.x, G, (bf16_t*)(ws + OFF_Z0), (const bf16_t*)(ws + OFF_ZGA));
            xcd_barrier(xb);
            {
                const bf16_t* FT = (const bf16_t*)(ws + OFF_ZFT); bf16_t* PQ = (bf16_t*)((unsigned char*)PP.out + DO_PQ);
                { FRESH_IDS();
                for (int job = gw; job < 12 * 512; job += NGW) {
                    const int seq = job >> 9, ch = job & 511;
                    const int S = seq < 8 ? 2048 : 4096; const size_t tok0 = seq < 8 ? (size_t)seq * 2048 : (size_t)TP + (size_t)(seq - 8) * 4096;
                    const bf16_t* fp = FT + (size_t)ch * T + tok0;
                    float a = 0.f;
                    for (int s0 = lane * 8; s0 < S; s0 += 512) { const u32x4 v = *(const u32x4*)(fp + s0);
#pragma unroll
                        for (int e = 0; e < 4; ++e) a += bf_lo(v[e]) - bf_hi(v[e]); }
                    a = wave_sum(a) * (S == 2048 ? 0.02209708691207961f : 0.015625f);
                    if (lane == 0) { bf16_t* o = PQ + (tok0 + S / 2) * 1024 + (ch >> 7) * 256 + (ch & 127); o[0] = (bf16_t)(cvt_pk_bf16(a, 0.f) & 0xffffu); o[128] = 0; }
                }
                }
                __syncthreads();

                { pg8::DftSched S{G, (int)blockIdx.x, true, (const char*)PP.out + DO_TRIG, (const char*)PP.out + DO_FE, (const char*)PP.out + DO_FO}; EpiDft E{PQ, FT, 1}; pg8::gemm_phase(lds, 2048, 4096, T / 2, S, E); }

                { pg8::DftSched S{G, (int)blockIdx.x, false, (const char*)PP.out + DO_TRIG, (const char*)PP.out + DO_FE, (const char*)PP.out + DO_FO}; EpiDft E{PQ, FT, 0}; pg8::gemm_phase(lds, 1024, 8192, T / 2, S, E); }
            }
            xcd_barrier(xb);

            chanmix_phase(PP, lds, li, threadIdx.x, G, (bf16_t*)(ws + OFF_Z0));
            xcd_barrier(xb);
            __syncthreads();

            { pg8::GemmSched S; S.init(T, 2048, G, blockIdx.x, ws + OFF_Z0, 2048, WOUT, 2048);
              EpiOut<layer == 0, false> E{PP.x_prompt, PP.x_sample, PP.out, XB, RSS};
              pg8::gemm_phase(lds, 2048, 2048, 2048, S, E); }
            xcd_barrier(xb);
        } else {
            { FRESH_IDS(); wconv<0>(PP.w_out_o + (size_t)li * 2048 * 2048, 2048, WOUT, nullptr, scr, gw, NGW, lane); }
            __syncthreads();

            { pg8::GemmSched S; S.init(T, 7168, G, blockIdx.x, XB, 2048, WIN, 2048); EpiIn<true> E{RSS, ws}; pg8::gemm_phase(lds, 2048, 2048, 2048, S, E); }
            xcd_barrier(xb);
            if (!last_layer) { FRESH_IDS(); wconv<1>(PP.w_in_e + (size_t)(li + 1) * 2048 * 5120, 5120, WIN, PP.norm_gain + (layer + 1) * D, scr, gw, NGW, lane); }
            __syncthreads();
            conv_phase(PP, li, threadIdx.x, NGW, (bf16_t*)(ws + OFF_Z0));

            sgu_phase(PP, lds, li, threadIdx.x, G, (bf16_t*)(ws + OFF_Z0));
            xcd_barrier(xb);
            __syncthreads();

            { pg8::GemmSched S; S.init(T, 2048, G, blockIdx.x, ws + OFF_Z0, 2048, WOUT, 2048);
              EpiOut<false, layer == 3> E{PP.x_prompt, PP.x_sample, PP.out, XB, RSS};
              pg8::gemm_phase(lds, 2048, 2048, 2048, S, E); }
            if (!last_layer) xcd_barrier(xb);
        }
}

__global__ void __launch_bounds__(512, 2) hybrid_fwd(Params p) {
    extern __shared__ __attribute__((aligned(16))) unsigned char lds_raw[];
    LAS unsigned char* lds = (LAS unsigned char*)lds_raw;
    cg::grid_group grid = cg::this_grid();
    unsigned char* ws = p.ws;
    XcdBarrier xb; xb.bar = (unsigned*)(ws + OFF_BAR); xb.x = xb_xcc_id();
    if (threadIdx.x == 0) (void)xb_add(&xb.bar[XB_XCNT(xb.x)], 1u);
    const int G = gridDim.x, NGW = G * 8, NT = G * 512;
    bf16_t* XB = (bf16_t*)(ws + OFF_XB); float* RSS = (float*)(ws + OFF_RSS);
    bf16_t* WIN = (bf16_t*)(ws + OFF_WIN); bf16_t* WOUT = (bf16_t*)(ws + OFF_WOUT);
    { FRESH_IDS();
    for (int t = gw; t < T; t += NGW) {
        const float* xr = (t < TP) ? p.x_prompt + (size_t)t * D : p.x_sample + (size_t)(t - TP) * D;
        const f32x4* x4 = (const f32x4*)xr + lane;
        unsigned long long* o8 = (unsigned long long*)(XB + (size_t)t * D) + lane;
        float s = 0.f;
        f32x4 xv[8];
#pragma unroll
        for (int j = 0; j < 8; ++j) xv[j] = x4[64 * j];
#pragma unroll
        for (int j = 0; j < 8; ++j) { const f32x4 v = xv[j]; s += (v[0] * v[0] + v[1] * v[1]) + (v[2] * v[2] + v[3] * v[3]);
            o8[64 * j] = (unsigned long long)cvt_pk_bf16(v[0], v[1]) | ((unsigned long long)cvt_pk_bf16(v[2], v[3]) << 32); }
        s = wave_sum(s);
        if (lane < 8) RSS[(size_t)t * 8 + lane] = (lane == 0) ? s : 0.f;
    }
    wconv<1>(p.w_in_e, 5120, WIN, p.norm_gain, scr, gw, NGW, lane);
    wconv<0>(p.w_out_e, 2048, WOUT, nullptr, scr, gw, NGW, lane);
    {
        bf16_t* TR = (bf16_t*)((unsigned char*)p.out + DO_TRIG);
        for (int i = gtid; i < 2 * 2048 * 512; i += NT) {
            const int s8 = (i & 511) * 8, k = (i >> 9) & 2047, cs = i >> 20;
            float v[8];
#pragma unroll
            for (int e = 0; e < 8; ++e) { const float ang = (float)((k * (s8 + e)) & 4095) * (1.f / 2048.f); v[e] = cs ? sinpif(ang) : cospif(ang); }
            u32x4 o; o.x = cvt_pk_bf16(v[0], v[1]); o.y = cvt_pk_bf16(v[2], v[3]); o.z = cvt_pk_bf16(v[4], v[5]); o.w = cvt_pk_bf16(v[6], v[7]);
            *(u32x4*)(TR + (size_t)cs * 2048 * 4096 + (size_t)k * 4096 + s8) = o;
        }
    }
    {
        float* bt = (float*)(ws + OFF_BIAS);
        for (int i = gtid; i < 2 * 12 * 260; i += NT) {
            const int lh = i / 260, o = i - lh * 260, li2 = lh / 12, h = lh - li2 * 12;
            float mg = 0.f, mb = 0.f;
            for (int d = 0; d < 128; ++d) mg = fmaxf(mg, fabsf(p.q_gain[li2 * 128 + d] * p.k_gain[li2 * 128 + d]));
            for (int q = 0; q < 32 * 12; ++q) mb = fmaxf(mb, fabsf(p.rel_bias[q]));
            const float B2 = (11.313708498984761f * mg * 1.01f + mb + 0.1f) * LOG2E;
            float v = 0.f;
            if (o <= 256) v = p.rel_bias[t5_bucket(o - 128) * 12 + h] * LOG2E - B2;
            else if (o == 257) v = p.sink[li2 * 12 + h] * LOG2E - B2;
            bt[i] = v;
        }
        bf16_t* W2 = (bf16_t*)(ws + OFF_W2);
        for (int i = gtid; i < 2 * 4 * 128 * 256; i += NT) {
            const int j = i & 255, d = (i >> 8) & 127, lg = i >> 15, c = j & 127;
            const float* wf = p.w_f + (size_t)lg * 128 * 128 + d;
            float a = 0.f;
#pragma unroll 16
            for (int m = 0; m < 128; ++m) { const float ang = (float)((m * c) & 127) * (1.f / 64.f); const float tv = (j < 128) ? cospif(ang) : -sinpif(ang); a += tv * wf[m * 128]; }
            W2[i] = (bf16_t)(cvt_pk_bf16(a * 0.08838834764831845f, 0.f) & 0xffffu);
        }
        bf16_t* WSB = (bf16_t*)(ws + OFF_WSB);
        for (int i = gtid; i < 2 * 8 * 128 * 128 / 2; i += NT) ((unsigned*)WSB)[i] = cvt_pk_bf16(p.w_s[2 * i], p.w_s[2 * i + 1]);
    }
    }
    grid.sync();
    { unsigned mine = 0u, cnt = 0u;
#pragma unroll
      for (unsigned j = 0; j < 16; ++j) { const unsigned c = xb_ld(&xb.bar[XB_XCNT(j)]); cnt += (c > 0u) ? 1u : 0u; mine = (j == xb.x) ? c : mine; }
      xb.nloc = __builtin_amdgcn_readfirstlane(mine > 0u ? mine : 1u); xb.nx = __builtin_amdgcn_readfirstlane(cnt > 0u ? cnt : 1u); }

    run_layer<0>(lds, xb);
    run_layer<1>(lds, xb);
    run_layer<2>(lds, xb);
    run_layer<3>(lds, xb);
}

extern "C" void kernel_launch(void* const* d_in, const int* in_sizes, int n_in, void* d_out, int out_size, void* d_ws, size_t ws_size, hipStream_t stream) {
    static int grid_blocks = 0;
    if (grid_blocks == 0) {
        if (n_in != 17 || ws_size < WS_NEED) { fprintf(stderr, "kernel_launch: n_in %d ws %zu (need %zu)\n", n_in, ws_size, (size_t)WS_NEED); grid_blocks = -1; return; }
        int dev = 0, cus = 0, per_cu = 0;
        hipGetDevice(&dev);
        hipDeviceGetAttribute(&cus, hipDeviceAttributeMultiprocessorCount, dev);
        if (hipFuncSetAttribute((const void*)hybrid_fwd, hipFuncAttributeMaxDynamicSharedMemorySize, LDS_BYTES) != hipSuccess) { fprintf(stderr, "kernel_launch: hipFuncSetAttribute failed\n"); grid_blocks = -1; return; }
        if (hipOccupancyMaxActiveBlocksPerMultiprocessor(&per_cu, (const void*)hybrid_fwd, 512, LDS_BYTES) != hipSuccess || per_cu < 1) { fprintf(stderr, "kernel_launch: occupancy query gave %d\n", per_cu); per_cu = 1; }
        (void)hipGetLastError();
        grid_blocks = cus * 1;
        fprintf(stderr, "kernel_launch: grid %d (cus %d, per_cu %d), ws %zu\n", grid_blocks, cus, per_cu, ws_size);
    }
    if (grid_blocks < 0) return;
    Params p{};
    p.x_prompt = (const float*)d_in[0]; p.x_sample = (const float*)d_in[1]; p.norm_gain = (const float*)d_in[2]; p.rel_bias = (const float*)d_in[3];
    p.w_in_e = (const float*)d_in[4]; p.w_out_e = (const float*)d_in[5]; p.q_gain = (const float*)d_in[6]; p.k_gain = (const float*)d_in[7]; p.sink = (const float*)d_in[8];
    p.w_f = (const float*)d_in[9]; p.b_f = (const float*)d_in[10]; p.w_in_o = (const float*)d_in[11]; p.conv_w = (const float*)d_in[12]; p.v_gain = (const float*)d_in[13];
    p.w_s = (const float*)d_in[14]; p.b_s = (const float*)d_in[15]; p.w_out_o = (const float*)d_in[16];
    p.out = (float*)d_out; p.ws = (unsigned char*)d_ws;
    if (hipMemsetAsync((char*)d_ws + OFF_BAR, 0, 16384, stream) != hipSuccess) { fprintf(stderr, "kernel_launch: memset failed\n"); return; }
    void* args[] = {&p};
    hipError_t e = hipLaunchCooperativeKernel((const void*)hybrid_fwd, dim3(grid_blocks), dim3(512), args, LDS_BYTES, stream);
    if (e != hipSuccess) fprintf(stderr, "cooperative launch failed: %s (grid %d)\n", hipGetErrorString(e), grid_blocks);
}
```

```cpp
#include <hip/hip_runtime.h>
#include <hip/hip_cooperative_groups.h>
#include <cstdio>
#include <cstdint>
namespace cg = cooperative_groups;

#define LAS __attribute__((address_space(3)))
typedef unsigned short bf16_t;
typedef short bf16x8 __attribute__((ext_vector_type(8)));
typedef float f32x4 __attribute__((ext_vector_type(4)));
typedef unsigned u32x4 __attribute__((ext_vector_type(4)));
typedef unsigned u32x2 __attribute__((ext_vector_type(2)));

constexpr int T = 32768, TP = 16384, D = 2048;
constexpr float EPS = 1e-6f;
constexpr float LOG2E = 1.4426950408889634f;
constexpr size_t MiB = 1048576;
constexpr size_t OFF_BIAS = 0;
constexpr size_t OFF_W2   = 0x10000;
constexpr size_t OFF_WSB  = 0x90000;
constexpr size_t OFF_BAR  = 0x180000;
constexpr size_t OFF_RSS  = 2 * MiB;
constexpr size_t OFF_VSS  = 6 * MiB;
constexpr size_t OFF_WIN  = 10 * MiB;
constexpr size_t OFF_WOUT = 38 * MiB;
constexpr size_t OFF_XB   = 46 * MiB;
constexpr size_t DO_PQ = 0, DO_TRIG = 64 * MiB, DO_FE = 96 * MiB, DO_FO = 112 * MiB;
constexpr size_t TRIG_HALF = (size_t)2048 * 4096 * 2;
constexpr size_t OFF_Z    = 174 * MiB;
constexpr size_t OFF_Z0   = OFF_Z;
constexpr size_t OFF_ZK   = OFF_Z + 128 * MiB;
constexpr size_t OFF_ZVT  = OFF_Z + 160 * MiB;
constexpr size_t OFF_ZGA  = OFF_Z + 192 * MiB;
constexpr size_t OFF_ZFT  = OFF_Z + 288 * MiB;
constexpr size_t OFF_ZM   = OFF_Z + 128 * MiB;
constexpr size_t OFF_ZVT2 = OFF_Z + 192 * MiB;
constexpr size_t WS_NEED  = OFF_Z + 320 * MiB;

constexpr int LDS_BYTES = 163840;
constexpr int XLDS_OFF = 131072;

struct Params {
    const float *x_prompt, *x_sample, *norm_gain, *rel_bias, *w_in_e, *w_out_e, *q_gain, *k_gain, *sink, *w_f, *b_f, *w_in_o, *conv_w, *v_gain, *w_s, *b_s, *w_out_o;
    float* out; unsigned char* ws;
};

__device__ __forceinline__ unsigned cvt_pk_bf16(float lo, float hi) { unsigned r; asm("v_cvt_pk_bf16_f32 %0, %1, %2" : "=v"(r) : "v"(lo), "v"(hi)); return r; }
__device__ __forceinline__ float bf_lo(unsigned u) { return __builtin_bit_cast(float, u << 16); }
__device__ __forceinline__ float bf_hi(unsigned u) { return __builtin_bit_cast(float, u & 0xffff0000u); }
__device__ __forceinline__ float silu_f(float x) { return x * __builtin_amdgcn_rcpf(1.f + __builtin_amdgcn_exp2f(-LOG2E * x)); }
__device__ __forceinline__ float wave_sum(float v) {
#pragma unroll
    for (int o = 1; o < 64; o <<= 1) v += __shfl_xor(v, o);
    return v;
}
#define LDS_WAIT() asm volatile("s_waitcnt lgkmcnt(0)" ::: "memory")

namespace pg8 {
constexpr int BM = 256, BK = 64, HALF = 128, HTB = HALF * BK * 2, NXCD = 8, WGM = 8;
__device__ __forceinline__ int lds_byte(int r, int c) { const int st = (r >> 4) * 2 + (c >> 5), rr = r & 15, cc = c & 31, ob = rr * 64 + cc * 2; return st * 1024 + (ob ^ (((ob >> 9) & 1) << 5)); }
__device__ __forceinline__ void stage_rc(int b, int& R, int& C) { const int st = b / 1024, sb = b % 1024, swz = sb ^ (((sb >> 9) & 1) << 5); R = (st >> 1) * 16 + swz / 64; C = (st & 1) * 32 + (swz % 64) / 2; }
__device__ __forceinline__ int perm32(int rho) { const int n = rho >> 4, i = rho & 15; return 8 * (i >> 2) + 4 * n + (i & 3); }

struct Unit { int pm, pn, aux; };

struct GemmSched {
    int nM, nN, nwg, G, c; const char* A; const char* B; size_t tA, tB;
    __device__ void init(int M, int N, int G_, int c_, const void* A_, size_t lda, const void* B_, size_t ldb) { nM = M / BM; nN = N / BM; nwg = nM * nN; G = G_; c = c_; A = (const char*)A_; B = (const char*)B_; tA = 256 * lda * 2; tB = 256 * ldb * 2; }
    __device__ bool next(int i, Unit& u) const {
        const long L = (long)i * G + c; if (L >= nwg) return false;
        int wgid = (int)L; { const int q = nwg / NXCD, r = nwg % NXCD, xcd = wgid % NXCD, off = wgid / NXCD; wgid = (xcd < r ? xcd * (q + 1) : r * (q + 1) + (xcd - r) * q) + off; }
        const int nig = WGM * nN, gid = wgid / nig, fm = gid * WGM, gsz = (nM - fm) < WGM ? (nM - fm) : WGM;
        u.pm = fm + ((wgid % nig) % gsz); u.pn = (wgid % nig) / gsz; u.aux = 0; return true;
    }
    __device__ const char* aptr(const Unit& u) const { return A + (size_t)u.pm * tA; }
    __device__ const char* bptr(const Unit& u) const { return B + (size_t)u.pn * tB; }
};

struct DftSched {
    int G, c; bool lng; const char* trig; const char* fe; const char* fo;
    __device__ bool next(int i, Unit& u) const {
        const long L = (long)i * G + (lng ? c : (G - 1 - c)); if (L >= 128) return false;
        const int l = (int)L;
        if (lng) { u.aux = l >> 5; u.pm = (l & 31) >> 1; u.pn = l & 1; } else { u.aux = l >> 4; u.pm = (l & 15) >> 1; u.pn = l & 1; }
        return true;
    }
    __device__ const char* aptr(const Unit& u) const {
        if (lng) { const int cs = u.pm >= 8, k0 = (u.pm - 8 * cs) * 256; return trig + (size_t)cs * TRIG_HALF + (size_t)k0 * 4096 * 2; }
        const int cs = u.pm >= 4, k0 = (u.pm - 4 * cs) * 256; return trig + (size_t)cs * TRIG_HALF + (size_t)(2 * k0) * 4096 * 2;
    }
    __device__ const char* bptr(const Unit& u) const {
        const int cs = lng ? (u.pm >= 8) : (u.pm >= 4);
        const size_t tok = lng ? (size_t)TP + (size_t)u.aux * 4096 : (size_t)u.aux * 2048;
        return (cs ? fo : fe) + ((size_t)u.pn * 256 * (T / 2) + tok / 2) * 2;
    }
};

template <class Epi, class Sched>
__device__ __forceinline__ void gemm_phase(LAS unsigned char* lds, const int K, const int lda, const int ldb, const Sched& S, const Epi& E) {
    int tid = threadIdx.x; asm volatile("" : "+v"(tid));
    const int wid = __builtin_amdgcn_readfirstlane(tid >> 6), lane = tid & 63, wr = wid >> 2, wc = wid & 3, fr = lane & 15, fq = lane >> 4;
    const int nt = K / BK;
    unsigned voffA[2], voffB[2];
#pragma unroll
    for (int i = 0; i < 2; ++i) { int R, C; stage_rc(tid * 16 + i * 8192, R, C); const int Rb = (R & ~31) + perm32(R & 31);
        voffA[i] = (unsigned)(R * lda + C) * 2u; voffB[i] = (unsigned)(Rb * ldb + C) * 2u; }
    const size_t kstep = (size_t)(BK * 2);
    const size_t hA = (size_t)HALF * lda * 2, hB = (size_t)HALF * ldb * 2;
    const unsigned ldsw = (unsigned)wid * 1024u;
    const int aoff = lds_byte(wr * 64 + fr, fq * 8), boff = lds_byte(wc * 32 + fr, fq * 8);
#define PG8_SA(b, h) (((b) * 2 + (h)) * HTB)
#define PG8_SB(b, h) ((4 + (b) * 2 + (h)) * HTB)
#define PG8_STAGE(bufoff, gbase, voff) do { _Pragma("unroll") for (int _i = 0; _i < 2; ++_i) \
        __builtin_amdgcn_global_load_lds((const unsigned*)((const char*)(gbase) + (voff)[_i]), (LAS unsigned*)(lds + (bufoff) + ldsw + _i * 8192), 16, 0, 0); } while (0)
#define PG8_LDA(dst, b, h) do { _Pragma("unroll") for (int m = 0; m < 4; ++m) _Pragma("unroll") for (int k = 0; k < 2; ++k) dst[m][k] = *(const LAS bf16x8*)(lds + PG8_SA(b, h) + aoff + m * 2048 + k * 1024); } while (0)
#define PG8_LDB(dst, b, h) do { _Pragma("unroll") for (int n = 0; n < 2; ++n) _Pragma("unroll") for (int k = 0; k < 2; ++k) dst[n][k] = *(const LAS bf16x8*)(lds + PG8_SB(b, h) + boff + n * 2048 + k * 1024); } while (0)
#define PG8_MMA(ai, bj, At, Bt) do { __builtin_amdgcn_s_setprio(1); _Pragma("unroll") for (int m = 0; m < 4; ++m) _Pragma("unroll") for (int n = 0; n < 2; ++n) _Pragma("unroll") for (int k = 0; k < 2; ++k) \
        acc[ai][bj][m][n] = __builtin_amdgcn_mfma_f32_16x16x32_bf16(Bt[n][k], At[m][k], acc[ai][bj][m][n], 0, 0, 0); __builtin_amdgcn_s_setprio(0); } while (0)
#define PG8_WAIT_V(n) asm volatile("s_waitcnt vmcnt(" #n ")" ::: "memory")
#define PG8_WAIT_L(n) asm volatile("s_waitcnt lgkmcnt(" #n ")" ::: "memory")
#define PG8_BAR __builtin_amdgcn_s_barrier()
#define PG8_SCHED __builtin_amdgcn_sched_barrier(0)
    Unit cur, nxt; int ui = 0;
    if (!S.next(0, cur)) return;
    f32x4 acc[2][2][4][2];
#pragma unroll
    for (int a = 0; a < 2; ++a)
#pragma unroll
        for (int b = 0; b < 2; ++b)
#pragma unroll
            for (int m = 0; m < 4; ++m)
#pragma unroll
                for (int n = 0; n < 2; ++n) acc[a][b][m][n] = (f32x4){0.f, 0.f, 0.f, 0.f};
    bf16x8 At[4][2], B0[2][2], B1[2][2];
    const char* cA = S.aptr(cur); const char* cB = S.bptr(cur);
    PG8_STAGE(PG8_SB(0, 0), cB, voffB); PG8_STAGE(PG8_SB(0, 1), cB + hB, voffB); PG8_STAGE(PG8_SA(0, 0), cA, voffA); PG8_STAGE(PG8_SA(0, 1), cA + hA, voffA);
    if (wr == 1) PG8_BAR;
    PG8_WAIT_V(2); PG8_BAR;
    PG8_STAGE(PG8_SB(1, 0), cB + kstep, voffB); PG8_STAGE(PG8_SA(1, 0), cA + kstep, voffA); PG8_STAGE(PG8_SB(1, 1), cB + hB + kstep, voffB);
    PG8_WAIT_V(6); PG8_BAR;
    for (;;) {
        const bool has_next = S.next(ui + 1, nxt);
        const char* nA = has_next ? S.aptr(nxt) : cA; const char* nB = has_next ? S.bptr(nxt) : cB;
        for (int t = 0; t < nt; t += 2) {
            const bool last = (t == nt - 2);
            const char* a1 = cA + (size_t)(t + 1) * kstep;
            const char* a2 = last ? nA : cA + (size_t)(t + 2) * kstep; const char* b2 = last ? nB : cB + (size_t)(t + 2) * kstep;
            const char* a3 = a2 + kstep; const char* b3 = b2 + kstep;
            PG8_LDB(B0, 0, 0); PG8_LDB(B1, 0, 1); PG8_SCHED; PG8_LDA(At, 0, 0); PG8_STAGE(PG8_SA(1, 1), a1 + hA, voffA);
            PG8_WAIT_V(8); PG8_WAIT_L(0); PG8_BAR; PG8_MMA(0, 0, At, B0); PG8_MMA(0, 1, At, B1); PG8_BAR; PG8_SCHED;
            PG8_LDA(At, 0, 1); PG8_STAGE(PG8_SB(0, 0), b2, voffB); PG8_STAGE(PG8_SB(0, 1), b2 + hB, voffB); PG8_STAGE(PG8_SA(0, 0), a2, voffA);
            PG8_WAIT_V(8); PG8_WAIT_L(0); PG8_BAR; PG8_MMA(1, 0, At, B0); PG8_MMA(1, 1, At, B1); PG8_BAR; PG8_SCHED;
            PG8_LDB(B0, 1, 0); PG8_LDB(B1, 1, 1); PG8_SCHED; PG8_LDA(At, 1, 0); PG8_STAGE(PG8_SA(0, 1), a2 + hA, voffA);
            PG8_WAIT_V(8); PG8_WAIT_L(0); PG8_BAR; PG8_MMA(0, 0, At, B0); PG8_MMA(0, 1, At, B1); PG8_BAR; PG8_SCHED;
            PG8_LDA(At, 1, 1); PG8_STAGE(PG8_SB(1, 0), b3, voffB); PG8_STAGE(PG8_SB(1, 1), b3 + hB, voffB); PG8_STAGE(PG8_SA(1, 0), a3, voffA);
            PG8_WAIT_V(8); PG8_WAIT_L(0); PG8_BAR; PG8_MMA(1, 0, At, B0); PG8_MMA(1, 1, At, B1); PG8_BAR; PG8_SCHED;
        }
        if (wr == 0) PG8_BAR;
        E(acc, cur, wr, wc, fr, fq, lds + XLDS_OFF, wid, lane);
        if (!has_next) break;
#pragma unroll
        for (int a = 0; a < 2; ++a)
#pragma unroll
            for (int b = 0; b < 2; ++b)
#pragma unroll
                for (int m = 0; m < 4; ++m)
#pragma unroll
                    for (int n = 0; n < 2; ++n) acc[a][b][m][n] = (f32x4){0.f, 0.f, 0.f, 0.f};
        cur = nxt; cA = nA; cB = nB; ++ui;
        if (wr == 1) PG8_BAR;
    }
    PG8_WAIT_V(0);
    PG8_BAR;
#undef PG8_SA
#undef PG8_SB
#undef PG8_STAGE
#undef PG8_LDA
#undef PG8_LDB
#undef PG8_MMA
#undef PG8_WAIT_V
#undef PG8_WAIT_L
#undef PG8_BAR
#undef PG8_SCHED
}
}
using pg8::Unit;

__device__ __forceinline__ void tstore_sub(const f32x4 (&v)[4][2], bf16_t* dst  , LAS unsigned char* x, int fr, int fq, int lane) {
#pragma unroll
    for (int m = 0; m < 4; ++m)
#pragma unroll
        for (int n = 0; n < 2; ++n)
#pragma unroll
            for (int j = 0; j < 4; ++j) {
                const int ch = 8 * fq + 4 * n + j, tok = 16 * m + fr;
                const unsigned b = cvt_pk_bf16(v[m][n][j], 0.f);
                *(LAS unsigned short*)(x + ch * 128 + ((((tok >> 3) ^ fq) << 4) | ((tok & 7) << 1))) = (unsigned short)b;
            }
    LDS_WAIT();
#pragma unroll
    for (int i = 0; i < 4; ++i) {
        const int q = lane + 64 * i, ch = q >> 3, tc = q & 7;
        const u32x4 o = *(const LAS u32x4*)(x + ch * 128 + ((tc ^ ((ch >> 3) & 3)) << 4));
        *(u32x4*)(dst + (size_t)ch * T + tc * 8) = o;
    }
    LDS_WAIT();
}

template <bool ODD> struct EpiIn {
    const float* rss; unsigned char* ws;
    __device__ __forceinline__ void operator()(const f32x4 (&acc)[2][2][4][2], const Unit& u, int wr, int wc, int fr, int fq, LAS unsigned char* xs, int wid, int lane) const {
        LAS unsigned char* x = xs + wid * 4096;
        const int row0 = u.pm * 256 + wr * 64;
        float rs[2][4];
#pragma unroll
        for (int ai = 0; ai < 2; ++ai) {
            const f32x4* pp = (const f32x4*)(rss + (size_t)(row0 + ai * 128 + lane) * 8);
            const f32x4 v0 = pp[0], v1 = pp[1];
            const float s = ((v0[0] + v0[1]) + (v0[2] + v0[3])) + ((v1[0] + v1[1]) + (v1[2] + v1[3]));
            const float r = rsqrtf(s * (1.f / D) + EPS);
#pragma unroll
            for (int m = 0; m < 4; ++m) rs[ai][m] = __shfl(r, 16 * m + fr);
        }
        const int pn = u.pn;
        int mode; bf16_t* base; int ldc;
        if (!ODD) {
            if (pn < 8) { mode = 0; base = (bf16_t*)(ws + OFF_Z0) + 256 * pn; ldc = 2048; }
            else if (pn < 10) { mode = 0; base = (bf16_t*)(ws + OFF_ZK) + 256 * (pn - 8); ldc = 512; }
            else if (pn < 16) { mode = 0; base = (bf16_t*)(ws + OFF_ZGA) + 256 * (pn - 10); ldc = 1536; }
            else if (pn < 18) { mode = 3; base = (bf16_t*)(ws + OFF_ZVT) + (size_t)256 * (pn - 16) * T; ldc = 0; }
            else { mode = 3; base = (bf16_t*)(ws + OFF_ZFT) + (size_t)256 * (pn - 18) * T; ldc = 0; }
        } else {
            if (pn < 8) { mode = 1; base = (bf16_t*)(ws + OFF_ZM) + 128 * pn; ldc = 1024; }
            else if (pn < 24) { mode = 2; base = (bf16_t*)(ws + OFF_Z0) + 128 * (pn - 8); ldc = 2048; }
            else { mode = 3; base = (bf16_t*)(ws + OFF_ZVT2) + (size_t)256 * (pn - 24) * T; ldc = 0; }
        }
        if (mode == 0) {
#pragma unroll
            for (int ai = 0; ai < 2; ++ai)
#pragma unroll
                for (int m = 0; m < 4; ++m) {
                    const float r = rs[ai][m];
                    bf16_t* rowp = base + (size_t)(row0 + ai * 128 + m * 16 + fr) * ldc + wc * 32 + 8 * fq;
#pragma unroll
                    for (int bj = 0; bj < 2; ++bj) { const f32x4 v0 = acc[ai][bj][m][0] * r, v1 = acc[ai][bj][m][1] * r;
                        u32x4 w; w.x = cvt_pk_bf16(v0[0], v0[1]); w.y = cvt_pk_bf16(v0[2], v0[3]); w.z = cvt_pk_bf16(v1[0], v1[1]); w.w = cvt_pk_bf16(v1[2], v1[3]);
                        *(u32x4*)(rowp + bj * 128) = w; }
                    __builtin_amdgcn_sched_barrier(0);
                }
        } else if (mode == 1 || mode == 2) {
#pragma unroll
            for (int ai = 0; ai < 2; ++ai)
#pragma unroll
                for (int m = 0; m < 4; ++m) {
                    const float r = rs[ai][m];
                    bf16_t* rowp = base + (size_t)(row0 + ai * 128 + m * 16 + fr) * ldc + wc * 32 + 8 * fq;
                    float o[8];
#pragma unroll
                    for (int n = 0; n < 2; ++n)
#pragma unroll
                        for (int j = 0; j < 4; ++j) { const float a = acc[ai][0][m][n][j] * r, b = acc[ai][1][m][n][j] * r; o[4 * n + j] = (mode == 1) ? a * b : a * silu_f(b); }
                    u32x4 w; w.x = cvt_pk_bf16(o[0], o[1]); w.y = cvt_pk_bf16(o[2], o[3]); w.z = cvt_pk_bf16(o[4], o[5]); w.w = cvt_pk_bf16(o[6], o[7]);
                    *(u32x4*)rowp = w;
                    __builtin_amdgcn_sched_barrier(0);
                }
        } else {
#pragma unroll
            for (int ai = 0; ai < 2; ++ai)
#pragma unroll
                for (int bj = 0; bj < 2; ++bj) {
                    f32x4 v[4][2];
#pragma unroll
                    for (int m = 0; m < 4; ++m) { v[m][0] = acc[ai][bj][m][0] * rs[ai][m]; v[m][1] = acc[ai][bj][m][1] * rs[ai][m]; }
                    if (ODD) {
                        float* vss = (float*)(ws + OFF_VSS);
#pragma unroll
                        for (int m = 0; m < 4; ++m) {
                            float s = 0.f;
#pragma unroll
                            for (int n = 0; n < 2; ++n) s += (v[m][n][0] * v[m][n][0] + v[m][n][1] * v[m][n][1]) + (v[m][n][2] * v[m][n][2] + v[m][n][3] * v[m][n][3]);
                            s += __shfl_xor(s, 16); s += __shfl_xor(s, 32);
                            if (fq == 0) vss[(size_t)(row0 + ai * 128 + m * 16 + fr) * 32 + (2 * (pn - 24) + bj) * 4 + wc] = s;
                        }
                    }
                    tstore_sub(v, base + (size_t)(bj * 128 + wc * 32) * T + row0 + ai * 128, x, fr, fq, lane);
                }
        }
    }
};

template <bool SRCF32, bool LAST> struct EpiOut {
    const float* xo_p; const float* xo_s;
    float* out; bf16_t* xb; float* rss;
    __device__ __forceinline__ void operator()(const f32x4 (&acc)[2][2][4][2], const Unit& u, int wr, int wc, int fr, int fq, LAS unsigned char* xs, int wid, int lane) const {
        const int row0 = u.pm * 256 + wr * 64, col0 = u.pn * 256 + wc * 32 + 8 * fq;
        const float* xo = (row0 < TP) ? xo_p : xo_s - (size_t)TP * D;
        LAS float* P = (LAS float*)xs;
        u32x4 raw[2][4][2];
        if (!SRCF32) {
#pragma unroll
            for (int ai = 0; ai < 2; ++ai)
#pragma unroll
                for (int m = 0; m < 4; ++m)
#pragma unroll
                    for (int bj = 0; bj < 2; ++bj) raw[ai][m][bj] = *(const u32x4*)(xb + (size_t)(row0 + ai * 128 + m * 16 + fr) * D + col0 + bj * 128);
        }
#pragma unroll
        for (int ai = 0; ai < 2; ++ai) {
            f32x4 xf[4][2][2];
            if (SRCF32) {
#pragma unroll
                for (int m = 0; m < 4; ++m)
#pragma unroll
                    for (int bj = 0; bj < 2; ++bj) { const size_t o = (size_t)(row0 + ai * 128 + m * 16 + fr) * D + col0 + bj * 128; xf[m][bj][0] = *(const f32x4*)(xo + o); xf[m][bj][1] = *(const f32x4*)(xo + o + 4); }
            }
#pragma unroll
            for (int m = 0; m < 4; ++m) {
                const size_t row = (size_t)(row0 + ai * 128 + m * 16 + fr);
                float ss = 0.f;
#pragma unroll
                for (int bj = 0; bj < 2; ++bj) {
                    const size_t o = row * D + col0 + bj * 128;
                    f32x4 x0, x1;
                    if (SRCF32) { x0 = xf[m][bj][0]; x1 = xf[m][bj][1]; }
                    else { const u32x4 r = raw[ai][m][bj]; x0 = (f32x4){bf_lo(r.x), bf_hi(r.x), bf_lo(r.y), bf_hi(r.y)}; x1 = (f32x4){bf_lo(r.z), bf_hi(r.z), bf_lo(r.w), bf_hi(r.w)}; }
                    const f32x4 v0 = x0 + acc[ai][bj][m][0], v1 = x1 + acc[ai][bj][m][1];
                    if (LAST) { *(f32x4*)(out + o) = v0; *(f32x4*)(out + o + 4) = v1; }
                    else {
                        ss += (v0[0] * v0[0] + v0[1] * v0[1]) + (v0[2] * v0[2] + v0[3] * v0[3]) + (v1[0] * v1[0] + v1[1] * v1[1]) + (v1[2] * v1[2] + v1[3] * v1[3]);
                        u32x4 w; w.x = cvt_pk_bf16(v0[0], v0[1]); w.y = cvt_pk_bf16(v0[2], v0[3]); w.z = cvt_pk_bf16(v1[0], v1[1]); w.w = cvt_pk_bf16(v1[2], v1[3]); *(u32x4*)(xb + o) = w;
                    }
                }
                if (!LAST) { ss += __shfl_xor(ss, 16); ss += __shfl_xor(ss, 32);
                    if (fq == 0) P[(ai * 128 + wr * 64 + m * 16 + fr) * 4 + wc] = ss; }
            }
            if (SRCF32) __builtin_amdgcn_sched_barrier(0);
        }
        if (!LAST) {
            LDS_WAIT();
            __builtin_amdgcn_s_barrier();
            const int tid = wid * 64 + lane;
            if (tid < 256) { const f32x4 v = *(const LAS f32x4*)(P + tid * 4); rss[(size_t)(u.pm * 256 + tid) * 8 + u.pn] = (v[0] + v[1]) + (v[2] + v[3]); }
            LDS_WAIT();
        }
    }
};

struct EpiDft {
    bf16_t* pq; const bf16_t* ft; int lng;
    __device__ __forceinline__ void operator()(const f32x4 (&acc)[2][2][4][2], const Unit& u, int wr, int wc, int fr, int fq, LAS unsigned char* xs, int wid, int lane) const {
        const int S = lng ? 4096 : 2048, hp = lng ? 8 : 4;
        const int cs = u.pm >= hp, k0 = (u.pm - hp * cs) * 256 + wr * 64;
        const size_t tok0 = lng ? (size_t)TP + (size_t)u.aux * 4096 : (size_t)u.aux * 2048;
        const float sc = lng ? 0.015625f : 0.02209708691207961f;
        const float scm = cs ? -sc : sc;
        float hv[2][8];
        const float csm = cs ? 0.f : 1.f;
#pragma unroll
        for (int bj = 0; bj < 2; ++bj)
#pragma unroll
            for (int e = 0; e < 8; ++e) {
                const unsigned short h = ft[(size_t)(u.pn * 256 + bj * 128 + wc * 32 + 8 * fq + e) * T + tok0 + S / 2];
                const float v = __builtin_bit_cast(float, (unsigned)h << 16) * csm;
                hv[bj][e] = (fr & 1) ? -v : v;
            }
#pragma unroll
        for (int ai = 0; ai < 2; ++ai)
#pragma unroll
            for (int m = 0; m < 4; ++m) {
                const int k = k0 + ai * 128 + m * 16 + fr;
#pragma unroll
                for (int bj = 0; bj < 2; ++bj) {
                    const int col = (2 * u.pn + bj) * 256 + cs * 128 + wc * 32 + 8 * fq;
                    f32x4 a = acc[ai][bj][m][0], b = acc[ai][bj][m][1];
#pragma unroll
                    for (int j = 0; j < 4; ++j) { a[j] += hv[bj][j]; b[j] += hv[bj][4 + j]; }
                    u32x4 w; w.x = cvt_pk_bf16(a[0] * sc, a[1] * sc); w.y = cvt_pk_bf16(a[2] * sc, a[3] * sc); w.z = cvt_pk_bf16(b[0] * sc, b[1] * sc); w.w = cvt_pk_bf16(b[2] * sc, b[3] * sc);
                    *(u32x4*)(pq + (tok0 + k) * 1024 + col) = w;
                    if (k > 0) {
                        u32x4 w2; w2.x = cvt_pk_bf16(a[0] * scm, a[1] * scm); w2.y = cvt_pk_bf16(a[2] * scm, a[3] * scm); w2.z = cvt_pk_bf16(b[0] * scm, b[1] * scm); w2.w = cvt_pk_bf16(b[2] * scm, b[3] * scm);
                        *(u32x4*)(pq + (tok0 + S - k) * 1024 + col) = w2;
                    }
                }
                __builtin_amdgcn_sched_barrier(0);
            }
    }
};

__device__ __forceinline__ int map_even(int n) {
    if (n < 1536) return n;
    if (n < 2048) return 4608 + (n - 1536);
    if (n < 2560) return 1536 + (n - 2048);
    if (n < 4096) return 3072 + (n - 2560);
    if (n < 4608) return 2048 + (n - 4096);
    return 2560 + (n - 4608);
}
__device__ __forceinline__ int map_odd(int n) {
    const int pn = n >> 8, half = (n >> 7) & 1, off = n & 127;
    if (pn < 8) return (half ? 2048 : 0) + 128 * pn + off;
    if (pn < 16) return (half ? 3072 : 1024) + 128 * (pn - 8) + off;
    if (pn < 24) return (half ? 6144 : 4096) + 128 * (pn - 16) + off;
    return 5120 + (n - 6144);
}
template <int MODE>
__device__ __forceinline__ void wconv(const float* W, int N, bf16_t* WT, const float* gain, LAS float* scr, int gw, int NGW, int lane) {
    const int nblk = N / 64, nitems = 32 * nblk;
    for (int item = gw; item < nitems; item += NGW) {
        const int kb = item / nblk, nb = item % nblk, k0 = 64 * kb, n0 = 64 * nb;
        const int s0 = MODE == 0 ? n0 : (MODE == 1 ? map_even(n0) : map_odd(n0));
        const int kr = lane >> 4, n4 = (lane & 15) * 4;
        f32x4 v[16];
#pragma unroll
        for (int i = 0; i < 16; ++i) v[i] = *(const f32x4*)(W + (size_t)(k0 + 4 * i + kr) * N + s0 + n4);
#pragma unroll
        for (int i = 0; i < 16; ++i) { const int kk = 4 * i + kr; const float g = gain ? gain[k0 + kk] : 1.f; LAS float* d = scr + kk * 65 + n4; d[0] = v[i][0] * g; d[1] = v[i][1] * g; d[2] = v[i][2] * g; d[3] = v[i][3] * g; }
        LDS_WAIT();
        const int c = lane & 7;
#pragma unroll
        for (int j = 0; j < 8; ++j) { const int n = (lane >> 3) + 8 * j; const LAS float* sp = scr + (8 * c) * 65 + n;
            u32x4 o; o.x = cvt_pk_bf16(sp[0 * 65], sp[1 * 65]); o.y = cvt_pk_bf16(sp[2 * 65], sp[3 * 65]); o.z = cvt_pk_bf16(sp[4 * 65], sp[5 * 65]); o.w = cvt_pk_bf16(sp[6 * 65], sp[7 * 65]);
            *(u32x4*)(WT + (size_t)(n0 + n) * 2048 + k0 + 8 * c) = o; }
        LDS_WAIT();
    }
}

__device__ __forceinline__ int t5_bucket(int rel) {
    const int n = rel < 0 ? -rel : rel;
    const int b = n < 8 ? n : 8 + (n >= 12) + (n >= 16) + (n >= 23) + (n >= 32) + (n >= 46) + (n >= 64) + (n >= 91);
    return (rel > 0 ? 16 : 0) + b;
}

__device__ __forceinline__ void attn_phase(const Params& p, LAS unsigned char* lds, int li, int tid, int G, bf16_t* __restrict__ dst, const bf16_t* __restrict__ ZGA) {
    asm volatile("" : "+v"(tid));
    unsigned char* ws = p.ws;
    const int w = __builtin_amdgcn_readfirstlane(tid >> 6);
    LAS float* BS = (LAS float*)(lds + 131072 + 1024);
    const bf16_t* Z0 = (const bf16_t*)(ws + OFF_Z0);
    const bf16_t* ZK = (const bf16_t*)(ws + OFF_ZK); const bf16_t* ZVT = (const bf16_t*)(ws + OFF_ZVT);
    auto dma_stage = [&](int item, int kb, int buf) {
        int l = tid & 63; asm volatile("" : "+v"(l));
        const int tb = item >> 2, hk = item & 3, tk = tb * 128 + (kb - 1) * 128;
        LAS unsigned char* kl = lds + buf * 65536; LAS unsigned char* vl = kl + 32768;
#pragma unroll
        for (int i = 0; i < 4; ++i) {
            const int r = 4 * (4 * w + i) + (l >> 4), c = (l & 15) ^ (r & 15);
            __builtin_amdgcn_global_load_lds((const unsigned*)(ZK + (size_t)(tk + r) * 512 + hk * 128 + c * 8), (LAS unsigned*)(kl + (4 * w + i) * 1024), 16, 0, 0);
            __builtin_amdgcn_global_load_lds((const unsigned*)(ZVT + (size_t)(hk * 128 + r) * T + tk + c * 8), (LAS unsigned*)(vl + (4 * w + i) * 1024), 16, 0, 0);
        }
    };
    int buf = 0, curhk = -1;
    int ibase, istep, icnt;
    if (G & 7) { ibase = blockIdx.x; istep = G; icnt = ibase < 1024 ? (1024 - ibase + G - 1) / G : 0; }
    else { const int nper = G >> 3, j0 = blockIdx.x >> 3; ibase = (blockIdx.x & 7) * 128 + j0; istep = nper; icnt = j0 < 128 ? (128 - j0 + nper - 1) / nper : 0; }
    u32x4 qraw[3][4];
    auto load_q = [&](int item, int lq_, int g_) {
        const int tb = item >> 2, hk = item & 3;
#pragma unroll
        for (int mb = 0; mb < 3; ++mb) {
            const int hh = mb, r = 16 * w + lq_;
            const bf16_t* qp = Z0 + (size_t)(tb * 128 + r) * 2048 + (3 * hk + hh) * 128 + 8 * g_;
#pragma unroll
            for (int ks = 0; ks < 4; ++ks) qraw[mb][ks] = *(const u32x4*)(qp + 32 * ks);
        }
    };
    if (icnt > 0) { dma_stage(ibase, 1, 0); load_q(ibase, tid & 15, (tid & 63) >> 4); }
    for (int kround = 0; kround < icnt; ++kround) {
        const int item = ibase + kround * istep;
        const int nitem = (kround + 1 < icnt) ? item + istep : -1;
        int l = tid & 63; asm volatile("" : "+v"(l));
        const int lq = l & 15, g = l >> 4;
        const int tb = item >> 2, hk = item & 3;
        const int nblk = tb < 128 ? 16 : 32, nbi = tb < 128 ? (tb & 15) : ((tb - 128) & 31);
        const int t0 = tb * 128;
        const bool has0 = nbi > 0, has2 = nbi < nblk - 1;
        const int nkb = 1 + (has0 ? 1 : 0) + (has2 ? 1 : 0);
        if (hk != curhk) {
            __syncthreads();
            const float* bt = (const float*)(ws + OFF_BIAS) + (size_t)(li * 12 + 3 * hk) * 260; for (int i = 64 * w + l; i < 3 * 260; i += 512) BS[i] = bt[i];
            curhk = hk;
        }
        bf16x8 Qf[3][4];
        {
            const float* qg = p.q_gain + li * 128; const float* kg = p.k_gain + li * 128;
#pragma unroll
            for (int mb = 0; mb < 3; ++mb) {
                u32x4 raw[4]; float ss = 0.f;
#pragma unroll
                for (int ks = 0; ks < 4; ++ks) { raw[ks] = qraw[mb][ks];
#pragma unroll
                    for (int e = 0; e < 4; ++e) { const float a = bf_lo(raw[ks][e]), b = bf_hi(raw[ks][e]); ss += a * a + b * b; } }
                ss += __shfl_xor(ss, 16); ss += __shfl_xor(ss, 32);
                const float rq = rsqrtf(ss * (1.f / 128.f) + EPS) * (0.08838834764831845f * LOG2E);
#pragma unroll
                for (int ks = 0; ks < 4; ++ks) {
                    const f32x4 g0 = *(const f32x4*)(qg + 32 * ks + 8 * g) * *(const f32x4*)(kg + 32 * ks + 8 * g), g1 = *(const f32x4*)(qg + 32 * ks + 8 * g + 4) * *(const f32x4*)(kg + 32 * ks + 8 * g + 4);
                    u32x4 o;
                    o.x = cvt_pk_bf16(bf_lo(raw[ks].x) * rq * g0[0], bf_hi(raw[ks].x) * rq * g0[1]);
                    o.y = cvt_pk_bf16(bf_lo(raw[ks].y) * rq * g0[2], bf_hi(raw[ks].y) * rq * g0[3]);
                    o.z = cvt_pk_bf16(bf_lo(raw[ks].z) * rq * g1[0], bf_hi(raw[ks].z) * rq * g1[1]);
                    o.w = cvt_pk_bf16(bf_lo(raw[ks].w) * rq * g1[2], bf_hi(raw[ks].w) * rq * g1[3]);
                    Qf[mb][ks] = __builtin_bit_cast(bf16x8, o);
                }
            }
        }
        f32x4 oacc[3][8];
        float lrun[3];
#pragma unroll
        for (int mb = 0; mb < 3; ++mb) {
            lrun[mb] = 0.f;
#pragma unroll
            for (int db = 0; db < 8; ++db) oacc[mb][db] = (f32x4){0.f, 0.f, 0.f, 0.f};
        }
#pragma unroll 1
        for (int step = 0; step < nkb; ++step) {
            const int kb = (step == 0) ? 1 : ((step == 1 && has0) ? 0 : 2);
            asm volatile("s_waitcnt vmcnt(0)" ::: "memory");
            LAS unsigned char* KS = lds + buf * 65536; LAS unsigned char* VS = KS + 32768;
            {
                const int key = 16 * w + (l >> 2), part = l & 3;
                u32x4 v[4]; float ss = 0.f;
#pragma unroll
                for (int i = 0; i < 4; ++i) { v[i] = *(const LAS u32x4*)(KS + key * 256 + (((4 * part + i) ^ (key & 15)) << 4));
#pragma unroll
                    for (int e = 0; e < 4; ++e) { const float a = bf_lo(v[i][e]), b = bf_hi(v[i][e]); ss += a * a + b * b; } }
                ss += __shfl_xor(ss, 1); ss += __shfl_xor(ss, 2);
                const float rk = rsqrtf(ss * (1.f / 128.f) + EPS);
#pragma unroll
                for (int i = 0; i < 4; ++i) { u32x4 o;
#pragma unroll
                    for (int e = 0; e < 4; ++e) o[e] = cvt_pk_bf16(bf_lo(v[i][e]) * rk, bf_hi(v[i][e]) * rk);
                    *(LAS u32x4*)(KS + key * 256 + (((4 * part + i) ^ (key & 15)) << 4)) = o; }
            }
            __syncthreads();
            if (step + 1 < nkb) dma_stage(item, (step == 0 && has0) ? 0 : 2, buf ^ 1);
            else if (nitem >= 0) dma_stage(nitem, 1, buf ^ 1);
#pragma unroll 1
            for (int qt = 0; qt < 4; ++qt) {
                if ((kb == 0) ? (32 * qt + 31 < 16 * w) : ((kb == 2) ? (32 * qt > 16 * w + 15) : false)) continue;
                const bool nomask = (kb == 1) || ((kb == 0) ? (32 * qt >= 16 * w + 15) : (32 * qt + 31 <= 16 * w));
                f32x4 sacc[3][2];
#pragma unroll
                for (int mb = 0; mb < 3; ++mb) { sacc[mb][0] = (f32x4){0.f, 0.f, 0.f, 0.f}; sacc[mb][1] = (f32x4){0.f, 0.f, 0.f, 0.f}; }
#pragma unroll
                for (int ks = 0; ks < 4; ++ks)
#pragma unroll
                    for (int n = 0; n < 2; ++n) {
                        const bf16x8 Kf = *(const LAS bf16x8*)(KS + (32 * qt + 16 * n + lq) * 256 + (((4 * ks + g) ^ lq) << 4));
#pragma unroll
                        for (int mb = 0; mb < 3; ++mb) sacc[mb][n] = __builtin_amdgcn_mfma_f32_16x16x32_bf16(Kf, Qf[mb][ks], sacc[mb][n], 0, 0, 0);
                    }
                bf16x8 Pf[3];
#pragma unroll
                for (int mb = 0; mb < 3; ++mb) {
                    const int hh = mb, r = 16 * w + lq;
                    u32x4 o = {0u, 0u, 0u, 0u};
                    {
                        const int ib = 128 * kb - r + 32 * qt + 4 * g;
                        const LAS float* bh = BS + hh * 260;
                        float ls = 0.f; float pe[2][4];
                        if (nomask) {
#pragma unroll
                            for (int n = 0; n < 2; ++n)
#pragma unroll
                                for (int j = 0; j < 4; ++j) { const float e = __builtin_amdgcn_exp2f(sacc[mb][n][j] + bh[ib + 16 * n + j]); pe[n][j] = e; ls += e; }
                        } else {
#pragma unroll
                            for (int n = 0; n < 2; ++n)
#pragma unroll
                                for (int j = 0; j < 4; ++j) {
                                    const int idx = ib + 16 * n + j, ic = min(max(idx, 0), 256);
                                    const float e = __builtin_amdgcn_exp2f(sacc[mb][n][j] + bh[ic]);
                                    const float pv = (idx == ic) ? e : 0.f; pe[n][j] = pv; ls += pv;
                                }
                        }
                        lrun[mb] += ls;
                        o.x = cvt_pk_bf16(pe[0][0], pe[0][1]); o.y = cvt_pk_bf16(pe[0][2], pe[0][3]); o.z = cvt_pk_bf16(pe[1][0], pe[1][1]); o.w = cvt_pk_bf16(pe[1][2], pe[1][3]);
                    }
                    Pf[mb] = __builtin_bit_cast(bf16x8, o);
                }
#pragma unroll
                for (int db = 0; db < 8; ++db) {
                    const LAS unsigned char* vrow = VS + (16 * db + lq) * 256 + (g & 1) * 8;
                    const u32x2 lo = *(const LAS u32x2*)(vrow + (((4 * qt + (g >> 1)) ^ lq) << 4)), hi = *(const LAS u32x2*)(vrow + (((4 * qt + 2 + (g >> 1)) ^ lq) << 4));
                    u32x4 vv; vv.x = lo.x; vv.y = lo.y; vv.z = hi.x; vv.w = hi.y;
                    const bf16x8 Vf = __builtin_bit_cast(bf16x8, vv);
#pragma unroll
                    for (int mb = 0; mb < 3; ++mb) oacc[mb][db] = __builtin_amdgcn_mfma_f32_16x16x32_bf16(Vf, Pf[mb], oacc[mb][db], 0, 0, 0);
                }
            }
            buf ^= 1;
        }
        u32x2 gv[3][8];
#pragma unroll
        for (int mb = 0; mb < 3; ++mb) {
            const int hh = mb, r = 16 * w + lq;
            const bf16_t* gp = ZGA + (size_t)(t0 + r) * 1536 + (3 * hk + hh) * 128 + 4 * g;
#pragma unroll
            for (int db = 0; db < 8; ++db) gv[mb][db] = *(const u32x2*)(gp + 16 * db);
        }
        load_q(nitem >= 0 ? nitem : item, lq, g);
#pragma unroll
        for (int mb = 0; mb < 3; ++mb) {
            const int hh = mb, r = 16 * w + lq;
            const size_t tok = (size_t)(t0 + r); const int hcol = (3 * hk + hh) * 128 + 4 * g;
            float lt = lrun[mb]; lt += __shfl_xor(lt, 16); lt += __shfl_xor(lt, 32);
            lt += __builtin_amdgcn_exp2f(BS[hh * 260 + 257]);
            const float inv = 1.f / lt;
#pragma unroll
            for (int db = 0; db < 8; ++db) {
                const f32x4 o = oacc[mb][db] * inv;
                u32x2 wv; wv.x = cvt_pk_bf16(o[0] * silu_f(bf_lo(gv[mb][db].x)), o[1] * silu_f(bf_hi(gv[mb][db].x))); wv.y = cvt_pk_bf16(o[2] * silu_f(bf_lo(gv[mb][db].y)), o[3] * silu_f(bf_hi(gv[mb][db].y)));
                *(u32x2*)(dst + tok * 2048 + hcol + 16 * db) = wv;
            }
        }
    }
    asm volatile("s_waitcnt vmcnt(0)" ::: "memory");
    __syncthreads();
}

__device__ __forceinline__ void chanmix_phase(const Params& p, LAS unsigned char* lds, int li, int tid, int G, bf16_t* dst) {
    asm volatile("" : "+v"(tid));
    unsigned char* ws = p.ws;
    const int w = tid >> 6, l = tid & 63, lq = l & 15, g4 = l >> 4;
    const bf16_t* PQ = (const bf16_t*)((unsigned char*)p.out + DO_PQ); bf16_t* Z0 = (bf16_t*)(ws + OFF_Z0);
    int curg = -1;
    bf16x8 Bf[8]; u32x2 gv[8];
    int item = blockIdx.x;
    if (item < 1024) {
        const int tb = item >> 2, g = item & 3; const size_t tok = (size_t)(tb * 128 + 16 * w + lq);
#pragma unroll
        for (int ks = 0; ks < 8; ++ks) Bf[ks] = *(const bf16x8*)(PQ + tok * 1024 + g * 256 + 32 * ks + 8 * g4);
#pragma unroll
        for (int db = 0; db < 8; ++db) gv[db] = *(const u32x2*)(Z0 + tok * 2048 + 1536 + g * 128 + 16 * db + 4 * g4);
    }
    for (; item < 1024; item += G) {
        const int tb = item >> 2, g = item & 3, t0 = tb * 128;
        if (g != curg) {
            __syncthreads();
            const bf16_t* W2 = (const bf16_t*)(ws + OFF_W2) + (size_t)(li * 4 + g) * 128 * 256;
            for (int q = tid; q < 4096; q += 512) { const int row = q >> 5, c16 = q & 31; *(LAS u32x4*)(lds + row * 528 + c16 * 16) = *(const u32x4*)(W2 + row * 256 + c16 * 8); }
            __syncthreads();
            curg = g;
        }
        const size_t tok = (size_t)(t0 + 16 * w + lq);
        f32x4 acc[8];
#pragma unroll
        for (int db = 0; db < 8; ++db) { acc[db] = (f32x4){0.f, 0.f, 0.f, 0.f};
#pragma unroll
            for (int ks = 0; ks < 8; ++ks) { const bf16x8 Af = *(const LAS bf16x8*)(lds + (16 * db + lq) * 528 + (32 * ks + 8 * g4) * 2); acc[db] = __builtin_amdgcn_mfma_f32_16x16x32_bf16(Af, Bf[ks], acc[db], 0, 0, 0); } }
        u32x2 gc[8];
#pragma unroll
        for (int db = 0; db < 8; ++db) gc[db] = gv[db];
        const int nitem = item + G;
        if (nitem < 1024) {
            const int tb2 = nitem >> 2, g2 = nitem & 3; const size_t tok2 = (size_t)(tb2 * 128 + 16 * w + lq);
#pragma unroll
            for (int ks = 0; ks < 8; ++ks) Bf[ks] = *(const bf16x8*)(PQ + tok2 * 1024 + g2 * 256 + 32 * ks + 8 * g4);
#pragma unroll
            for (int db = 0; db < 8; ++db) gv[db] = *(const u32x2*)(Z0 + tok2 * 2048 + 1536 + g2 * 128 + 16 * db + 4 * g4);
        }
        const float* bf = p.b_f + (li * 4 + g) * 128;
        f32x4 bv[8];
#pragma unroll
        for (int db = 0; db < 8; ++db) bv[db] = *(const f32x4*)(bf + 16 * db + 4 * g4);
#pragma unroll
        for (int db = 0; db < 8; ++db) {
            const int d = 16 * db + 4 * g4;
            bf16_t* zp = dst + tok * 2048 + 1536 + g * 128 + d;
            const f32x4 b = bv[db];
            u32x2 o; o.x = cvt_pk_bf16((acc[db][0] + b[0]) * silu_f(bf_lo(gc[db].x)), (acc[db][1] + b[1]) * silu_f(bf_hi(gc[db].x)));
            o.y = cvt_pk_bf16((acc[db][2] + b[2]) * silu_f(bf_lo(gc[db].y)), (acc[db][3] + b[3]) * silu_f(bf_hi(gc[db].y)));
            *(u32x2*)zp = o;
        }
    }
}

__device__ __forceinline__ void conv_phase(const Params& p, int li, int tid, int NGW, bf16_t* dst) {
    asm volatile("" : "+v"(tid));
    unsigned char* ws = p.ws;
    const int lane = tid & 63, gw = blockIdx.x * 8 + (tid >> 6);
    const bf16_t* ZM = (const bf16_t*)(ws + OFF_ZM); bf16_t* Z0 = (bf16_t*)(ws + OFF_Z0);
    const float* cw = p.conv_w + (size_t)li * 3 * 1024;
    for (int job = gw; job < 2048; job += NGW) {
        const int seg = job >> 1, c8 = (job & 1) * 512 + lane * 8, t0 = seg * 32;
        const int S = t0 < TP ? 2048 : 4096, s0 = t0 & (S - 1);
        float w0[8], w1[8], w2[8];
#pragma unroll
        for (int e = 0; e < 2; ++e) { const f32x4 a = *(const f32x4*)(cw + c8 + 4 * e), b = *(const f32x4*)(cw + 1024 + c8 + 4 * e), c = *(const f32x4*)(cw + 2048 + c8 + 4 * e);
#pragma unroll
            for (int j = 0; j < 4; ++j) { w0[4 * e + j] = a[j]; w1[4 * e + j] = b[j]; w2[4 * e + j] = c[j]; } }
        const u32x4 z = {0u, 0u, 0u, 0u};
        u32x4 mp = (s0 > 0) ? *(const u32x4*)(ZM + (size_t)(t0 - 1) * 1024 + c8) : z;
        u32x4 mc = *(const u32x4*)(ZM + (size_t)t0 * 1024 + c8);
#pragma unroll 1
        for (int ch = 0; ch < 4; ++ch) {
            u32x4 mn[8], bb[8];
#pragma unroll
            for (int i = 0; i < 8; ++i) { const int t = t0 + ch * 8 + i;
                mn[i] = (s0 + ch * 8 + i < S - 1) ? *(const u32x4*)(ZM + (size_t)(t + 1) * 1024 + c8) : z;
                bb[i] = *(const u32x4*)(Z0 + (size_t)t * 2048 + c8); }
#pragma unroll
            for (int i = 0; i < 8; ++i) {
                u32x4 o;
#pragma unroll
                for (int e = 0; e < 4; ++e) {
                    const float lo = bf_lo(bb[i][e]) * (w0[2 * e] * bf_lo(mp[e]) + w1[2 * e] * bf_lo(mc[e]) + w2[2 * e] * bf_lo(mn[i][e]));
                    const float hi = bf_hi(bb[i][e]) * (w0[2 * e + 1] * bf_hi(mp[e]) + w1[2 * e + 1] * bf_hi(mc[e]) + w2[2 * e + 1] * bf_hi(mn[i][e]));
                    o[e] = cvt_pk_bf16(lo, hi);
                }
                *(u32x4*)(dst + (size_t)(t0 + ch * 8 + i) * 2048 + c8) = o;
                mp = mc; mc = mn[i];
            }
        }
    }
}
__device__ __forceinline__ void sgu_phase(const Params& p, LAS unsigned char* lds, int li, int tid, int G, bf16_t* dst) {
    asm volatile("" : "+v"(tid));
    unsigned char* ws = p.ws;
    const int w = tid >> 6, l = tid & 63, lq = l & 15, g4 = l >> 4;
    const bf16_t* ZVT = (const bf16_t*)(ws + OFF_ZVT2); bf16_t* Z0 = (bf16_t*)(ws + OFF_Z0);
    const float* vss = (const float*)(ws + OFF_VSS);
    LAS float* RI = (LAS float*)(lds + 34816);
    const int c = tid >> 2, q0 = (tid & 3) * 32;
    u32x4 raw[4]; f32x4 vs = {1.f, 1.f, 1.f, 1.f};
    int item = blockIdx.x;
    if (item < 2048) {
        const int tb = item >> 3, g = item & 7, t0 = tb * 128;
#pragma unroll
        for (int i = 0; i < 4; ++i) raw[i] = *(const u32x4*)(ZVT + (size_t)(g * 128 + c) * T + t0 + q0 + 8 * i);
        if (tid < 128) vs = *(const f32x4*)(vss + (size_t)(t0 + tid) * 32 + g * 4);
    }
    for (; item < 2048; item += G) {
        const int tb = item >> 3, g = item & 7, t0 = tb * 128;
        __syncthreads();
        if (tid < 128) RI[tid] = rsqrtf(((vs[0] + vs[1]) + (vs[2] + vs[3])) * (1.f / 128.f) + EPS);
        const size_t tok = (size_t)(t0 + 16 * w + lq);
        const bf16_t* WS = (const bf16_t*)(ws + OFF_WSB) + (size_t)(li * 8 + g) * 128 * 128;
        bf16x8 Wf[4]; u32x2 uv[8];
#pragma unroll
        for (int ks = 0; ks < 4; ++ks) Wf[ks] = *(const bf16x8*)(WS + (16 * w + lq) * 128 + 32 * ks + 8 * g4);
#pragma unroll
        for (int cb = 0; cb < 8; ++cb) uv[cb] = *(const u32x2*)(Z0 + tok * 2048 + 1024 + g * 128 + 16 * cb + 4 * g4);
        __syncthreads();
#pragma unroll
        for (int i = 0; i < 4; ++i) {
            const LAS float* ri = RI + q0 + 8 * i;
            u32x4 o;
            o.x = cvt_pk_bf16(bf_lo(raw[i].x) * ri[0], bf_hi(raw[i].x) * ri[1]); o.y = cvt_pk_bf16(bf_lo(raw[i].y) * ri[2], bf_hi(raw[i].y) * ri[3]);
            o.z = cvt_pk_bf16(bf_lo(raw[i].z) * ri[4], bf_hi(raw[i].z) * ri[5]); o.w = cvt_pk_bf16(bf_lo(raw[i].w) * ri[6], bf_hi(raw[i].w) * ri[7]);
            *(LAS u32x4*)(lds + c * 272 + q0 * 2 + 16 * i) = o;
        }
        const int nitem = item + G;
        if (nitem < 2048) {
            const int tb2 = nitem >> 3, g2 = nitem & 7, t2 = tb2 * 128;
#pragma unroll
            for (int i = 0; i < 4; ++i) raw[i] = *(const u32x4*)(ZVT + (size_t)(g2 * 128 + c) * T + t2 + q0 + 8 * i);
            if (tid < 128) vs = *(const f32x4*)(vss + (size_t)(t2 + tid) * 32 + g2 * 4);
        }
        __syncthreads();
        f32x4 acc[8];
#pragma unroll
        for (int cb = 0; cb < 8; ++cb) { acc[cb] = (f32x4){0.f, 0.f, 0.f, 0.f};
#pragma unroll
            for (int ks = 0; ks < 4; ++ks) { const bf16x8 Af = *(const LAS bf16x8*)(lds + (16 * cb + lq) * 272 + (32 * ks + 8 * g4) * 2); acc[cb] = __builtin_amdgcn_mfma_f32_16x16x32_bf16(Af, Wf[ks], acc[cb], 0, 0, 0); } }
        const float bs = p.b_s[(li * 8 + g) * 128 + 16 * w + lq];
        const float* vg = p.v_gain + li * 1024 + g * 128;
        f32x4 gnv[8];
#pragma unroll
        for (int cb = 0; cb < 8; ++cb) gnv[cb] = *(const f32x4*)(vg + 16 * cb + 4 * g4);
#pragma unroll
        for (int cb = 0; cb < 8; ++cb) {
            const int cc = 16 * cb + 4 * g4;
            bf16_t* zp = dst + tok * 2048 + 1024 + g * 128 + cc;
            const f32x4 gn = gnv[cb];
            u32x2 o; o.x = cvt_pk_bf16(bf_lo(uv[cb].x) * (acc[cb][0] * gn[0] + bs), bf_hi(uv[cb].x) * (acc[cb][1] * gn[1] + bs));
            o.y = cvt_pk_bf16(bf_lo(uv[cb].y) * (acc[cb][2] * gn[2] + bs), bf_hi(uv[cb].y) * (acc[cb][3] * gn[3] + bs));
            *(u32x2*)zp = o;
        }
    }
}

#define XB_TMO      128
#define XB_XCNT(j)  (256  + 64 * (j))
#define XB_XSUB(j)  (1280 + 64 * (j))
#define XB_XGEN(j)  (2304 + 64 * (j))
#define XB_TOP      3328
#define XB_TOPGEN   3392
#define XCD_BAR_WORDS 3456
#define XB_SPIN_CAP (1u << 18)
__device__ __forceinline__ unsigned xb_ld(unsigned* p)              { return __hip_atomic_load(p, __ATOMIC_RELAXED, __HIP_MEMORY_SCOPE_AGENT); }
__device__ __forceinline__ unsigned xb_add(unsigned* p, unsigned v) { return __hip_atomic_fetch_add(p, v, __ATOMIC_RELAXED, __HIP_MEMORY_SCOPE_AGENT); }
__device__ __forceinline__ unsigned xb_xcc_id() { return (unsigned)__builtin_amdgcn_s_getreg((3 << 11) | 20) & 0xFu; }
#define XB_SPIN(cond, bar) do { unsigned _sp = 0; while (cond) { __builtin_amdgcn_s_sleep(1); \
    if ((++_sp & 255u) == 0u) { if (xb_ld(&(bar)[XB_TMO])) break; if (_sp > XB_SPIN_CAP) { atomicAdd(&(bar)[XB_TMO], 1u); break; } } } } while (0)
struct XcdBarrier { unsigned* bar; unsigned x, nloc, nx; };
__device__ __forceinline__ void xcd_barrier(const XcdBarrier& b) {
    asm volatile("s_waitcnt vmcnt(0)" ::: "memory");
    __syncthreads();
    if (threadIdx.x == 0) {
        unsigned* bar = b.bar;
        __builtin_amdgcn_s_waitcnt(0);
        const unsigned nloc = b.nloc, nx = b.nx;
        const unsigned old = xb_add(&bar[XB_XSUB(b.x)], 1u);
        const unsigned gen = old / nloc;
        if (old + 1u == (gen + 1u) * nloc) {
            __builtin_amdgcn_fence(__ATOMIC_RELEASE, "agent");
            asm volatile("s_waitcnt vmcnt(0)" ::: "memory");
            const unsigned og = xb_add(&bar[XB_TOP], 1u);
            const unsigned tg = og / nx;
            if (og + 1u == (tg + 1u) * nx) xb_add(&bar[XB_TOPGEN], 1u);
            else XB_SPIN(xb_ld(&bar[XB_TOPGEN]) == tg, bar);
            __builtin_amdgcn_fence(__ATOMIC_ACQUIRE, "agent");
            xb_add(&bar[XB_XGEN(b.x)], 1u);
            asm volatile("s_waitcnt vmcnt(0)" ::: "memory");
        } else {
            XB_SPIN(xb_ld(&bar[XB_XGEN(b.x)]) == gen, bar);
            __builtin_amdgcn_fence(__ATOMIC_ACQUIRE, "agent");
            asm volatile("s_waitcnt vmcnt(0)" ::: "memory");
        }
    }
    __syncthreads();
}

typedef const Params __attribute__((address_space(4)))* KParamsPtr;
__device__ __forceinline__ Params load_params() {
#if defined(__HIP_DEVICE_COMPILE__)
    KParamsPtr k = (KParamsPtr)__builtin_amdgcn_kernarg_segment_ptr(); asm volatile("" : "+s"(k));
    Params r;
    r.x_prompt = k->x_prompt; r.x_sample = k->x_sample; r.norm_gain = k->norm_gain; r.rel_bias = k->rel_bias; r.w_in_e = k->w_in_e; r.w_out_e = k->w_out_e; r.q_gain = k->q_gain; r.k_gain = k->k_gain;
    r.sink = k->sink; r.w_f = k->w_f; r.b_f = k->b_f; r.w_in_o = k->w_in_o; r.conv_w = k->conv_w; r.v_gain = k->v_gain; r.w_s = k->w_s; r.b_s = k->b_s; r.w_out_o = k->w_out_o; r.out = k->out; r.ws = k->ws;
    return r;
#else
    return Params{};
#endif
}
#define PP load_params()
#define FRESH_IDS() int tid = threadIdx.x; asm volatile("" : "+v"(tid)); const int lane = tid & 63, wave = tid >> 6; \
    const int gw = blockIdx.x * 8 + wave, gtid = blockIdx.x * 512 + tid; LAS float* scr = (LAS float*)(lds + wave * 16896); (void)lane; (void)gw; (void)gtid; (void)scr;

template <int layer>
__device__ __forceinline__ void run_layer(LAS unsigned char* lds, const XcdBarrier& xb) {
    unsigned char* ws = PP.ws;
    const int G = gridDim.x, NGW = G * 8, NT = G * 512;
    bf16_t* XB = (bf16_t*)(ws + OFF_XB); float* RSS = (float*)(ws + OFF_RSS);
    bf16_t* WIN = (bf16_t*)(ws + OFF_WIN); bf16_t* WOUT = (bf16_t*)(ws + OFF_WOUT);
    (void)NGW; (void)NT; (void)XB; (void)RSS; (void)WIN; (void)WOUT;

        const int li = layer >> 1;
        const bool last_layer = (layer == 3);
        if ((layer & 1) == 0) {
            if (layer > 0) { FRESH_IDS(); wconv<0>(PP.w_out_e + (size_t)li * 2048 * 2048, 2048, WOUT, nullptr, scr, gw, NGW, lane); }
            __syncthreads();

            { pg8::GemmSched S; S.init(T, 5120, G, blockIdx.x, XB, 2048, WIN, 2048); EpiIn<false> E{RSS, ws}; pg8::gemm_phase(lds, 2048, 2048, 2048, S, E); }
            xcd_barrier(xb);
            { FRESH_IDS();
            wconv<2>(PP.w_in_o + (size_t)li * 2048 * 7168, 7168, WIN, PP.norm_gain + (layer + 1) * D, scr, gw, NGW, lane);
            {
                const bf16_t* FT = (const bf16_t*)(ws + OFF_ZFT);
                bf16_t* FE = (bf16_t*)((unsigned char*)PP.out + DO_FE); bf16_t* FO = (bf16_t*)((unsigned char*)PP.out + DO_FO);
                constexpr int NFOLD = 512 * (T / 16);
                for (int i0 = gtid; i0 < NFOLD; i0 += 4 * NT) {
                    u32x4 own[4], mir[4]; unsigned short m0[4]; int s8v[4]; size_t dsto[4];
#pragma unroll
                    for (int u = 0; u < 4; ++u) {
                        const int i = min(i0 + u * NT, NFOLD - 1);
                        const int ch = i >> 11, h8 = (i & 2047) * 8;
                        int S, tok0, s8;
                        if (h8 < TP / 2) { S = 2048; tok0 = (h8 >> 10) * 2048; s8 = h8 & 1023; } else { S = 4096; const int q = h8 - TP / 2; tok0 = TP + (q >> 11) * 4096; s8 = q & 2047; }
                        const bf16_t* fp = FT + (size_t)ch * T + tok0;
                        own[u] = *(const u32x4*)(fp + s8);
                        mir[u] = *(const u32x4*)(fp + S - s8 - 8);
                        m0[u] = fp[s8 > 0 ? S - s8 : 0];
                        s8v[u] = s8; dsto[u] = (size_t)ch * (T / 2) + h8;
                    }
#pragma unroll
                    for (int u = 0; u < 4; ++u) {
                        if (i0 + u * NT < NFOLD) {
                            float a[8], b[8];
#pragma unroll
                            for (int e = 0; e < 4; ++e) { a[2 * e] = bf_lo(own[u][e]); a[2 * e + 1] = bf_hi(own[u][e]); }
                            b[0] = __builtin_bit_cast(float, (unsigned)m0[u] << 16);
#pragma unroll
                            for (int e = 1; e < 8; ++e) { const int q = 8 - e; b[e] = (q & 1) ? bf_hi(mir[u][q >> 1]) : bf_lo(mir[u][q >> 1]); }
                            float fe[8], fo[8];
#pragma unroll
                            for (int e = 0; e < 8; ++e) { fe[e] = a[e] + b[e]; fo[e] = a[e] - b[e]; }
                            if (s8v[u] == 0) { fe[0] = a[0]; fo[0] = 0.f; }
                            u32x4 oe, oo;
#pragma unroll
                            for (int e = 0; e < 4; ++e) { oe[e] = cvt_pk_bf16(fe[2 * e], fe[2 * e + 1]); oo[e] = cvt_pk_bf16(fo[2 * e], fo[2 * e + 1]); }
                            *(u32x4*)(FE + dsto[u]) = oe; *(u32x4*)(FO + dsto[u]) = oo;
                        }
                    }
                }
            }
            }
            __syncthreads();

            attn_phase(PP, lds, li, threadIdx.x, G, (bf16_t*)(ws + OFF_Z0), (const bf16_t*)(ws + OFF_ZGA));
            xcd_barrier(xb);
            {
                const bf16_t* FT = (const bf16_t*)(ws + OFF_ZFT); bf16_t* PQ = (bf16_t*)((unsigned char*)PP.out + DO_PQ);
                { FRESH_IDS();
                for (int job = gw; job < 12 * 512; job += NGW) {
                    const int seq = job >> 9, ch = job & 511;
                    const int S = seq < 8 ? 2048 : 4096; const size_t tok0 = seq < 8 ? (size_t)seq * 2048 : (size_t)TP + (size_t)(seq - 8) * 4096;
                    const bf16_t* fp = FT + (size_t)ch * T + tok0;
                    float a = 0.f;
                    for (int s0 = lane * 8; s0 < S; s0 += 512) { const u32x4 v = *(const u32x4*)(fp + s0);
#pragma unroll
                        for (int e = 0; e < 4; ++e) a += bf_lo(v[e]) - bf_hi(v[e]); }
                    a = wave_sum(a) * (S == 2048 ? 0.02209708691207961f : 0.015625f);
                    if (lane == 0) { bf16_t* o = PQ + (tok0 + S / 2) * 1024 + (ch >> 7) * 256 + (ch & 127); o[0] = (bf16_t)(cvt_pk_bf16(a, 0.f) & 0xffffu); o[128] = 0; }
                }
                }
                __syncthreads();

                { pg8::DftSched S{G, (int)blockIdx.x, true, (const char*)PP.out + DO_TRIG, (const char*)PP.out + DO_FE, (const char*)PP.out + DO_FO}; EpiDft E{PQ, FT, 1}; pg8::gemm_phase(lds, 2048, 4096, T / 2, S, E); }

                { pg8::DftSched S{G, (int)blockIdx.x, false, (const char*)PP.out + DO_TRIG, (const char*)PP.out + DO_FE, (const char*)PP.out + DO_FO}; EpiDft E{PQ, FT, 0}; pg8::gemm_phase(lds, 1024, 8192, T / 2, S, E); }
            }
            xcd_barrier(xb);

            chanmix_phase(PP, lds, li, threadIdx.x, G, (bf16_t*)(ws + OFF_Z0));
            xcd_barrier(xb);
            __syncthreads();

            { pg8::GemmSched S; S.init(T, 2048, G, blockIdx.x, ws + OFF_Z0, 2048, WOUT, 2048);
              EpiOut<layer == 0, false> E{PP.x_prompt, PP.x_sample, PP.out, XB, RSS};
              pg8::gemm_phase(lds, 2048, 2048, 2048, S, E); }
            xcd_barrier(xb);
        } else {
            { FRESH_IDS(); wconv<0>(PP.w_out_o + (size_t)li * 2048 * 2048, 2048, WOUT, nullptr, scr, gw, NGW, lane); }
            __syncthreads();

            { pg8::GemmSched S; S.init(T, 7168, G, blockIdx.x, XB, 2048, WIN, 2048); EpiIn<true> E{RSS, ws}; pg8::gemm_phase(lds, 2048, 2048, 2048, S, E); }
            xcd_barrier(xb);
            if (!last_layer) { FRESH_IDS(); wconv<1>(PP.w_in_e + (size_t)(li + 1) * 2048 * 5120, 5120, WIN, PP.norm_gain + (layer + 1) * D, scr, gw, NGW, lane); }
            __syncthreads();
            conv_phase(PP, li, threadIdx.x, NGW, (bf16_t*)(ws + OFF_Z0));

            sgu_phase(PP, lds, li, threadIdx.x, G, (bf16_t*)(ws + OFF_Z0));
            xcd_barrier(xb);
            __syncthreads();

            { pg8::GemmSched S; S.init(T, 2048, G, blockIdx.x, ws + OFF_Z0, 2048, WOUT, 2048);
              EpiOut<false, layer == 3> E{PP.x_prompt, PP.x_sample, PP.out, XB, RSS};
              pg8::gemm_phase(lds, 2048, 2048, 2048, S, E); }
            if (!last_layer) xcd_barrier(xb);
        }
}

__global__ void __launch_bounds__(512, 2) hybrid_fwd(Params p) {
    extern __shared__ __attribute__((aligned(16))) unsigned char lds_raw[];
    LAS unsigned char* lds = (LAS unsigned char*)lds_raw;
    cg::grid_group grid = cg::this_grid();
    unsigned char* ws = p.ws;
    XcdBarrier xb; xb.bar = (unsigned*)(ws + OFF_BAR); xb.x = xb_xcc_id();
    if (threadIdx.x == 0) (void)xb_add(&xb.bar[XB_XCNT(xb.x)], 1u);
    const int G = gridDim.x, NGW = G * 8, NT = G * 512;
    bf16_t* XB = (bf16_t*)(ws + OFF_XB); float* RSS = (float*)(ws + OFF_RSS);
    bf16_t* WIN = (bf16_t*)(ws + OFF_WIN); bf16_t* WOUT = (bf16_t*)(ws + OFF_WOUT);
    { FRESH_IDS();
    for (int t = gw; t < T; t += NGW) {
        const float* xr = (t < TP) ? p.x_prompt + (size_t)t * D : p.x_sample + (size_t)(t - TP) * D;
        const f32x4* x4 = (const f32x4*)xr + lane;
        unsigned long long* o8 = (unsigned long long*)(XB + (size_t)t * D) + lane;
        float s = 0.f;
        f32x4 xv[8];
#pragma unroll
        for (int j = 0; j < 8; ++j) xv[j] = x4[64 * j];
#pragma unroll
        for (int j = 0; j < 8; ++j) { const f32x4 v = xv[j]; s += (v[0] * v[0] + v[1] * v[1]) + (v[2] * v[2] + v[3] * v[3]);
            o8[64 * j] = (unsigned long long)cvt_pk_bf16(v[0], v[1]) | ((unsigned long long)cvt_pk_bf16(v[2], v[3]) << 32); }
        s = wave_sum(s);
        if (lane < 8) RSS[(size_t)t * 8 + lane] = (lane == 0) ? s : 0.f;
    }
    wconv<1>(p.w_in_e, 5120, WIN, p.norm_gain, scr, gw, NGW, lane);
    wconv<0>(p.w_out_e, 2048, WOUT, nullptr, scr, gw, NGW, lane);
    {
        bf16_t* TR = (bf16_t*)((unsigned char*)p.out + DO_TRIG);
        for (int i = gtid; i < 2 * 2048 * 512; i += NT) {
            const int s8 = (i & 511) * 8, k = (i >> 9) & 2047, cs = i >> 20;
            float v[8];
#pragma unroll
            for (int e = 0; e < 8; ++e) { const float ang = (float)((k * (s8 + e)) & 4095) * (1.f / 2048.f); v[e] = cs ? sinpif(ang) : cospif(ang); }
            u32x4 o; o.x = cvt_pk_bf16(v[0], v[1]); o.y = cvt_pk_bf16(v[2], v[3]); o.z = cvt_pk_bf16(v[4], v[5]); o.w = cvt_pk_bf16(v[6], v[7]);
            *(u32x4*)(TR + (size_t)cs * 2048 * 4096 + (size_t)k * 4096 + s8) = o;
        }
    }
    {
        float* bt = (float*)(ws + OFF_BIAS);
        for (int i = gtid; i < 2 * 12 * 260; i += NT) {
            const int lh = i / 260, o = i - lh * 260, li2 = lh / 12, h = lh - li2 * 12;
            float mg = 0.f, mb = 0.f;
            for (int d = 0; d < 128; ++d) mg = fmaxf(mg, fabsf(p.q_gain[li2 * 128 + d] * p.k_gain[li2 * 128 + d]));
            for (int q = 0; q < 32 * 12; ++q) mb = fmaxf(mb, fabsf(p.rel_bias[q]));
            const float B2 = (11.313708498984761f * mg * 1.01f + mb + 0.1f) * LOG2E;
            float v = 0.f;
            if (o <= 256) v = p.rel_bias[t5_bucket(o - 128) * 12 + h] * LOG2E - B2;
            else if (o == 257) v = p.sink[li2 * 12 + h] * LOG2E - B2;
            bt[i] = v;
        }
        bf16_t* W2 = (bf16_t*)(ws + OFF_W2);
        for (int i = gtid; i < 2 * 4 * 128 * 256; i += NT) {
            const int j = i & 255, d = (i >> 8) & 127, lg = i >> 15, c = j & 127;
            const float* wf = p.w_f + (size_t)lg * 128 * 128 + d;
            float a = 0.f;
#pragma unroll 16
            for (int m = 0; m < 128; ++m) { const float ang = (float)((m * c) & 127) * (1.f / 64.f); const float tv = (j < 128) ? cospif(ang) : -sinpif(ang); a += tv * wf[m * 128]; }
            W2[i] = (bf16_t)(cvt_pk_bf16(a * 0.08838834764831845f, 0.f) & 0xffffu);
        }
        bf16_t* WSB = (bf16_t*)(ws + OFF_WSB);
        for (int i = gtid; i < 2 * 8 * 128 * 128 / 2; i += NT) ((unsigned*)WSB)[i] = cvt_pk_bf16(p.w_s[2 * i], p.w_s[2 * i + 1]);
    }
    }
    grid.sync();
    { unsigned mine = 0u, cnt = 0u;
#pragma unroll
      for (unsigned j = 0; j < 16; ++j) { const unsigned c = xb_ld(&xb.bar[XB_XCNT(j)]); cnt += (c > 0u) ? 1u : 0u; mine = (j == xb.x) ? c : mine; }
      xb.nloc = __builtin_amdgcn_readfirstlane(mine > 0u ? mine : 1u); xb.nx = __builtin_amdgcn_readfirstlane(cnt > 0u ? cnt : 1u); }

    run_layer<0>(lds, xb);
    run_layer<1>(lds, xb);
    run_layer<2>(lds, xb);
    run_layer<3>(lds, xb);
}

extern "C" void kernel_launch(void* const* d_in, const int* in_sizes, int n_in, void* d_out, int out_size, void* d_ws, size_t ws_size, hipStream_t stream) {
    static int grid_blocks = 0;
    if (grid_blocks == 0) {
        if (n_in != 17 || ws_size < WS_NEED) { fprintf(stderr, "kernel_launch: n_in %d ws %zu (need %zu)\n", n_in, ws_size, (size_t)WS_NEED); grid_blocks = -1; return; }
        int dev = 0, cus = 0, per_cu = 0;
        hipGetDevice(&dev);
        hipDeviceGetAttribute(&cus, hipDeviceAttributeMultiprocessorCount, dev);
        if (hipFuncSetAttribute((const void*)hybrid_fwd, hipFuncAttributeMaxDynamicSharedMemorySize, LDS_BYTES) != hipSuccess) { fprintf(stderr, "kernel_launch: hipFuncSetAttribute failed\n"); grid_blocks = -1; return; }
        if (hipOccupancyMaxActiveBlocksPerMultiprocessor(&per_cu, (const void*)hybrid_fwd, 512, LDS_BYTES) != hipSuccess || per_cu < 1) { fprintf(stderr, "kernel_launch: occupancy query gave %d\n", per_cu); per_cu = 1; }
        (void)hipGetLastError();
        grid_blocks = cus * 1;
        fprintf(stderr, "kernel_launch: grid %d (cus %d, per_cu %d), ws %zu\n", grid_blocks, cus, per_cu, ws_size);
    }
    if (grid_blocks < 0) return;
    Params p{};
    p.x_prompt = (const float*)d_in[0]; p.x_sample = (const float*)d_in[1]; p.norm_gain = (const float*)d_in[2]; p.rel_bias = (const float*)d_in[3];
    p.w_in_e = (const float*)d_in[4]; p.w_out_e = (const float*)d_in[5]; p.q_gain = (const float*)d_in[6]; p.k_gain = (const float*)d_in[7]; p.sink = (const float*)d_in[8];
    p.w_f = (const float*)d_in[9]; p.b_f = (const float*)d_in[10]; p.w_in_o = (const float*)d_in[11]; p.conv_w = (const float*)d_in[12]; p.v_gain = (const float*)d_in[13];
    p.w_s = (const float*)d_in[14]; p.b_s = (const float*)d_in[15]; p.w_out_o = (const float*)d_in[16];
    p.out = (float*)d_out; p.ws = (unsigned char*)d_ws;
    if (hipMemsetAsync((char*)d_ws + OFF_BAR, 0, 16384, stream) != hipSuccess) { fprintf(stderr, "kernel_launch: memset failed\n"); return; }
    void* args[] = {&p};
    hipError_t e = hipLaunchCooperativeKernel((const void*)hybrid_fwd, dim3(grid_blocks), dim3(512), args, LDS_BYTES, stream);
    if (e != hipSuccess) fprintf(stderr, "cooperative launch failed: %s (grid %d)\n", hipGetErrorString(e), grid_blocks);
}
```
